# Optimizing an MI355X kernel written in HIP

```python
import math
import jax, jax.numpy as jnp
from jax import lax
import numpy as np

D_MODEL = 4096
BATCH = 4
SEQ = 2048
DEPTH = 2

HEAD_DIM = 128
ROPE_THETA = 10000.0
RMS_EPS = 1e-6
D_FF = 11008
Q_BLOCK = 128
NEG = -1e30
BIG = 1e9

FOX_HEADS = 16
DIFF_HEADS = 8
DIFF_V_DIM = 2 * HEAD_DIM
IN0_WIDTH = 3 * FOX_HEADS * HEAD_DIM + FOX_HEADS + 2 * DIFF_HEADS * 2 * HEAD_DIM + DIFF_HEADS * DIFF_V_DIM
MIX0_OUT = FOX_HEADS * HEAD_DIM + DIFF_HEADS * DIFF_V_DIM

NSA_HEADS = 32
NSA_KV_HEADS = 4
NSA_GROUP = NSA_HEADS // NSA_KV_HEADS
CMP_BLOCK = 32
CMP_STRIDE = 16
CMP_HIDDEN = 256
SEL_BLOCK = 64
N_SELECT = 16
WINDOW = 512
SEL_Q_CHUNK = 64
N_BRANCH = 3
IN1_WIDTH = NSA_HEADS * HEAD_DIM + 6 * NSA_KV_HEADS * HEAD_DIM + N_BRANCH * NSA_HEADS
MIX1_OUT = NSA_HEADS * HEAD_DIM

N_EVEN = (DEPTH + 1) // 2
N_ODD = DEPTH // 2

kernel_name = "hybrid_fox_diff_nsa_macaron"


def rms_norm(x, g):
    xf = x.astype(jnp.float32)
    y = xf * lax.rsqrt(jnp.mean(xf * xf, axis=-1, keepdims=True) + RMS_EPS)
    return (y * g.astype(jnp.float32)).astype(x.dtype)


def swiglu(x, w_gate, w_up, w_down):
    return (jax.nn.silu(x @ w_gate) * (x @ w_up)) @ w_down


def rope(x, pos):
    half = x.shape[-1] // 2
    inv = ROPE_THETA ** (-jnp.arange(half, dtype=jnp.float32) / half)
    ang = pos.astype(jnp.float32)[:, None] * inv[None, :]
    shape = (1, x.shape[1]) + (1,) * (x.ndim - 3) + (half,)
    cos = jnp.cos(ang).reshape(shape)
    sin = jnp.sin(ang).reshape(shape)
    x1 = x[..., :half].astype(jnp.float32)
    x2 = x[..., half:].astype(jnp.float32)
    return jnp.concatenate([x1 * cos - x2 * sin, x2 * cos + x1 * sin], axis=-1).astype(x.dtype)


def split_cols(proj, sizes):
    return jnp.split(proj, np.cumsum(sizes)[:-1].tolist(), axis=-1)


def fox_diff_mixer(h, w_in, b_forget, lq1, lk1, lq2, lk2, subln_g, w_out, lam_init):
    B, T, _ = h.shape
    proj = h @ w_in
    fq, fk, fv, fgate, dq, dk, dv = split_cols(
        proj, [FOX_HEADS * HEAD_DIM] * 3 + [FOX_HEADS] + [DIFF_HEADS * 2 * HEAD_DIM] * 2 + [DIFF_HEADS * DIFF_V_DIM])
    pos = jnp.arange(T)
    fq = fq.reshape(B, T, FOX_HEADS, HEAD_DIM)
    fk = fk.reshape(B, T, FOX_HEADS, HEAD_DIM)
    fv = fv.reshape(B, T, FOX_HEADS, HEAD_DIM)
    log_f = jax.nn.log_sigmoid(fgate.astype(jnp.float32) + b_forget.astype(jnp.float32))
    cum = jnp.transpose(jnp.cumsum(log_f, axis=1), (0, 2, 1))
    dq = rope(dq.reshape(B, T, DIFF_HEADS, 2, HEAD_DIM), pos)
    dk = rope(dk.reshape(B, T, DIFF_HEADS, 2, HEAD_DIM), pos)
    dv = dv.reshape(B, T, DIFF_HEADS, DIFF_V_DIM)
    lam = (jnp.exp(jnp.sum(lq1.astype(jnp.float32) * lk1.astype(jnp.float32)))
           - jnp.exp(jnp.sum(lq2.astype(jnp.float32) * lk2.astype(jnp.float32))) + lam_init)
    scale = HEAD_DIM ** -0.5

    def block(i):
        start = i * Q_BLOCK
        tq = start + jnp.arange(Q_BLOCK)
        causal = tq[:, None] >= pos[None, :]
        q = lax.dynamic_slice_in_dim(fq, start, Q_BLOCK, axis=1)
        cq = lax.dynamic_slice_in_dim(cum, start, Q_BLOCK, axis=2)
        s = jnp.einsum('bqhd,bshd->bhqs', q, fk).astype(jnp.float32) * scale
        s = s + (cq[..., :, None] - cum[..., None, :])
        p = jax.nn.softmax(jnp.where(causal, s, NEG), axis=-1)
        o_fox = jnp.einsum('bhqs,bshd->bqhd', p.astype(fv.dtype), fv)
        q2 = lax.dynamic_slice_in_dim(dq, start, Q_BLOCK, axis=1)
        s2 = jnp.einsum('bqhcd,bshcd->bhcqs', q2, dk).astype(jnp.float32) * scale
        p2 = jax.nn.softmax(jnp.where(causal, s2, NEG), axis=-1)
        a = p2[:, :, 0] - lam * p2[:, :, 1]
        o_diff = jnp.einsum('bhqs,bshe->bqhe', a.astype(dv.dtype), dv)
        return o_fox, o_diff

    o_fox, o_diff = lax.map(block, jnp.arange(T // Q_BLOCK))
    o_fox = jnp.moveaxis(o_fox, 0, 1).reshape(B, T, FOX_HEADS * HEAD_DIM)
    o_diff = jnp.moveaxis(o_diff, 0, 1).reshape(B, T, DIFF_HEADS, DIFF_V_DIM)
    o_diff = rms_norm(o_diff, subln_g) * (1.0 - lam_init)
    out = jnp.concatenate([o_fox, o_diff.reshape(B, T, DIFF_HEADS * DIFF_V_DIM)], axis=-1)
    return out @ w_out


def nsa_mixer(h, w_in, pe_k, k_w1, k_b1, k_w2, pe_v, v_w1, v_b1, v_w2, w_out):
    B, T, _ = h.shape
    G, R, d = NSA_KV_HEADS, NSA_GROUP, HEAD_DIM
    proj = h @ w_in
    q, kc, vc, ks, vs, kw, vw, gates = split_cols(proj, [NSA_HEADS * d] + [G * d] * 6 + [N_BRANCH * NSA_HEADS])
    q = q.reshape(B, T, G, R, d)
    kc, vc, ks, vs, kw, vw = [a.reshape(B, T, G, d) for a in (kc, vc, ks, vs, kw, vw)]
    gates = jax.nn.sigmoid(gates.astype(jnp.float32)).reshape(B, T, G, R, N_BRANCH).astype(h.dtype)
    pos = jnp.arange(T)
    q_rot = rope(q, pos)
    ks = rope(ks, pos)
    kw = rope(kw, pos)
    scale = d ** -0.5

    n_cmp = (T - CMP_BLOCK) // CMP_STRIDE + 1
    cmp_idx = np.arange(n_cmp)[:, None] * CMP_STRIDE + np.arange(CMP_BLOCK)[None, :]

    def compress(a, pe, w1, b1, w2):
        blk = a[:, cmp_idx] + pe[:, None, :]
        blk = jnp.moveaxis(blk, 3, 2).reshape(B, n_cmp, G, CMP_BLOCK * d)
        return jax.nn.silu(blk @ w1 + b1) @ w2

    k_cmp = compress(kc, pe_k, k_w1, k_b1, k_w2)
    v_cmp = compress(vc, pe_v, v_w1, v_b1, v_w2)
    cmp_mask = pos[:, None] >= jnp.asarray(cmp_idx[:, -1])[None, :]
    s = jnp.einsum('btgrd,bngd->bgrtn', q, k_cmp).astype(jnp.float32) * scale
    p_cmp = jax.nn.softmax(jnp.where(cmp_mask, s, NEG), axis=-1) * cmp_mask
    o_cmp = jnp.einsum('bgrtn,bngd->btgrd', p_cmp.astype(v_cmp.dtype), v_cmp)

    n_sel = T // SEL_BLOCK
    n_top = min(N_SELECT, n_sel)
    cmp_start = cmp_idx[:, 0]
    sel_start = np.arange(n_sel) * SEL_BLOCK
    overlap = ((cmp_start[:, None] < sel_start[None, :] + SEL_BLOCK)
               & (cmp_start[:, None] + CMP_BLOCK > sel_start[None, :])).astype(np.float32)
    imp = jnp.einsum('bgrtn,nj->bgtj', p_cmp, jnp.asarray(overlap))
    blk_t = pos // SEL_BLOCK
    j = jnp.arange(n_sel)
    valid = j[None, :] <= blk_t[:, None]
    forced = (j[None, :] == 0) | (j[None, :] == blk_t[:, None]) | (j[None, :] == blk_t[:, None] - 1)
    score = jnp.where(valid, jnp.where(forced, BIG, imp), -BIG)
    top_val, top_idx = lax.top_k(score, n_top)
    top_ok = top_val > -BIG / 2
    ks_blk = jnp.transpose(ks.reshape(B, n_sel, SEL_BLOCK, G, d), (0, 3, 1, 2, 4))
    vs_blk = jnp.transpose(vs.reshape(B, n_sel, SEL_BLOCK, G, d), (0, 3, 1, 2, 4))
    bi = jnp.arange(B)[:, None, None, None]
    gi = jnp.arange(G)[None, :, None, None]

    def sel_chunk(i):
        start = i * SEL_Q_CHUNK
        tq = start + jnp.arange(SEL_Q_CHUNK)
        qc = lax.dynamic_slice_in_dim(q_rot, start, SEL_Q_CHUNK, axis=1)
        idx = lax.dynamic_slice_in_dim(top_idx, start, SEL_Q_CHUNK, axis=2)
        ok = lax.dynamic_slice_in_dim(top_ok, start, SEL_Q_CHUNK, axis=2)
        kg = ks_blk[bi, gi, idx]
        vg = vs_blk[bi, gi, idx]
        key_pos = idx[..., None] * SEL_BLOCK + jnp.arange(SEL_BLOCK)
        mask = ok[..., None] & (key_pos <= tq[None, None, :, None, None])
        s = jnp.einsum('bqgrd,bgqkld->bgrqkl', qc, kg).astype(jnp.float32) * scale
        s = jnp.where(mask[:, :, None], s, NEG).reshape(B, G, R, SEL_Q_CHUNK, n_top * SEL_BLOCK)
        p = jax.nn.softmax(s, axis=-1).reshape(B, G, R, SEL_Q_CHUNK, n_top, SEL_BLOCK)
        return jnp.einsum('bgrqkl,bgqkld->bqgrd', p.astype(vg.dtype), vg)

    o_sel = lax.map(sel_chunk, jnp.arange(T // SEL_Q_CHUNK))
    o_sel = jnp.moveaxis(o_sel, 0, 1).reshape(B, T, G, R, d)

    kw_pad = jnp.pad(kw, ((0, 0), (WINDOW, 0), (0, 0), (0, 0)))
    vw_pad = jnp.pad(vw, ((0, 0), (WINDOW, 0), (0, 0), (0, 0)))
    span = WINDOW + Q_BLOCK

    def win_block(i):
        start = i * Q_BLOCK
        tq = start + jnp.arange(Q_BLOCK)
        kpos = start - WINDOW + jnp.arange(span)
        qb = lax.dynamic_slice_in_dim(q_rot, start, Q_BLOCK, axis=1)
        kb = lax.dynamic_slice_in_dim(kw_pad, start, span, axis=1)
        vb = lax.dynamic_slice_in_dim(vw_pad, start, span, axis=1)
        dist = tq[:, None] - kpos[None, :]
        mask = (kpos[None, :] >= 0) & (dist >= 0) & (dist < WINDOW)
        s = jnp.einsum('bqgrd,bsgd->bgrqs', qb, kb).astype(jnp.float32) * scale
        p = jax.nn.softmax(jnp.where(mask, s, NEG), axis=-1)
        return jnp.einsum('bgrqs,bsgd->bqgrd', p.astype(vb.dtype), vb)

    o_win = lax.map(win_block, jnp.arange(T // Q_BLOCK))
    o_win = jnp.moveaxis(o_win, 0, 1).reshape(B, T, G, R, d)

    out = gates[..., 0:1] * o_cmp + gates[..., 1:2] * o_sel + gates[..., 2:3] * o_win
    return out.reshape(B, T, MIX1_OUT) @ w_out


def setup_inputs(seed: int = 0) -> dict:
    key = jax.random.key(seed)
    keys = iter(jax.random.split(key, 32))

    def nrm(shape, scale):
        return jax.random.normal(next(keys), shape, jnp.float32) * scale

    def gain(shape):
        return 1.0 + 0.02 * jax.random.normal(next(keys), shape, jnp.float32)

    D = D_MODEL
    return {
        "x": nrm((BATCH, SEQ, D), 1.0),
        "ffn1_norm": gain((DEPTH, D)),
        "ffn1_w_gate": nrm((DEPTH, D, D_FF), D ** -0.5),
        "ffn1_w_up": nrm((DEPTH, D, D_FF), D ** -0.5),
        "ffn1_w_down": nrm((DEPTH, D_FF, D), D_FF ** -0.5),
        "mix_norm": gain((DEPTH, D)),
        "ffn2_norm": gain((DEPTH, D)),
        "ffn2_w_gate": nrm((DEPTH, D, D_FF), D ** -0.5),
        "ffn2_w_up": nrm((DEPTH, D, D_FF), D ** -0.5),
        "ffn2_w_down": nrm((DEPTH, D_FF, D), D_FF ** -0.5),
        "even_w_in": nrm((N_EVEN, D, IN0_WIDTH), D ** -0.5),
        "even_b_forget": nrm((N_EVEN, FOX_HEADS), 0.1),
        "even_lambda_q1": nrm((N_EVEN, HEAD_DIM), 0.1),
        "even_lambda_k1": nrm((N_EVEN, HEAD_DIM), 0.1),
        "even_lambda_q2": nrm((N_EVEN, HEAD_DIM), 0.1),
        "even_lambda_k2": nrm((N_EVEN, HEAD_DIM), 0.1),
        "even_subln": gain((N_EVEN, DIFF_V_DIM)),
        "even_w_out": nrm((N_EVEN, MIX0_OUT, D), MIX0_OUT ** -0.5),
        "odd_w_in": nrm((N_ODD, D, IN1_WIDTH), D ** -0.5),
        "odd_cmp_pe_k": nrm((N_ODD, CMP_BLOCK, HEAD_DIM), 0.02),
        "odd_cmp_k_w1": nrm((N_ODD, CMP_BLOCK * HEAD_DIM, CMP_HIDDEN), (CMP_BLOCK * HEAD_DIM) ** -0.5),
        "odd_cmp_k_b1": nrm((N_ODD, CMP_HIDDEN), 0.01),
        "odd_cmp_k_w2": nrm((N_ODD, CMP_HIDDEN, HEAD_DIM), CMP_HIDDEN ** -0.5),
        "odd_cmp_pe_v": nrm((N_ODD, CMP_BLOCK, HEAD_DIM), 0.02),
        "odd_cmp_v_w1": nrm((N_ODD, CMP_BLOCK * HEAD_DIM, CMP_HIDDEN), (CMP_BLOCK * HEAD_DIM) ** -0.5),
        "odd_cmp_v_b1": nrm((N_ODD, CMP_HIDDEN), 0.01),
        "odd_cmp_v_w2": nrm((N_ODD, CMP_HIDDEN, HEAD_DIM), CMP_HIDDEN ** -0.5),
        "odd_w_out": nrm((N_ODD, MIX1_OUT, D), MIX1_OUT ** -0.5),
        "final_norm": gain((D,)),
    }


def reference(x, ffn1_norm, ffn1_w_gate, ffn1_w_up, ffn1_w_down, mix_norm,
              ffn2_norm, ffn2_w_gate, ffn2_w_up, ffn2_w_down,
              even_w_in, even_b_forget, even_lambda_q1, even_lambda_k1, even_lambda_q2, even_lambda_k2,
              even_subln, even_w_out,
              odd_w_in, odd_cmp_pe_k, odd_cmp_k_w1, odd_cmp_k_b1, odd_cmp_k_w2,
              odd_cmp_pe_v, odd_cmp_v_w1, odd_cmp_v_b1, odd_cmp_v_w2, odd_w_out,
              final_norm):
    h = x
    for layer in range(DEPTH):
        h = h + 0.5 * swiglu(rms_norm(h, ffn1_norm[layer]), ffn1_w_gate[layer], ffn1_w_up[layer], ffn1_w_down[layer])
        hn = rms_norm(h, mix_norm[layer])
        i = layer // 2
        if layer % 2 == 0:
            lam_init = 0.8 - 0.6 * math.exp(-0.3 * layer)
            h = h + fox_diff_mixer(hn, even_w_in[i], even_b_forget[i], even_lambda_q1[i], even_lambda_k1[i],
                                   even_lambda_q2[i], even_lambda_k2[i], even_subln[i], even_w_out[i], lam_init)
        else:
            h = h + nsa_mixer(hn, odd_w_in[i], odd_cmp_pe_k[i], odd_cmp_k_w1[i], odd_cmp_k_b1[i], odd_cmp_k_w2[i],
                              odd_cmp_pe_v[i], odd_cmp_v_w1[i], odd_cmp_v_b1[i], odd_cmp_v_w2[i], odd_w_out[i])
        h = h + 0.5 * swiglu(rms_norm(h, ffn2_norm[layer]), ffn2_w_gate[layer], ffn2_w_up[layer], ffn2_w_down[layer])
    return rms_norm(h, final_norm)
```

```cpp
#include <hip/hip_runtime.h>
#include <hip/hip_bf16.h>
#include <cstdio>
#include <cstdint>

namespace pg8 {
#define PG8_LAS __attribute__((address_space(3)))
typedef unsigned short bf16_t;
typedef short bf16x8 __attribute__((ext_vector_type(8)));
typedef float f32x4 __attribute__((ext_vector_type(4)));
typedef unsigned u32x4 __attribute__((ext_vector_type(4)));
constexpr int BM = 256, BK = 64, HALF = 128, HTB = HALF * BK * 2  , STAGE_BYTES = 8 * HTB, NXCD = 8, WGM = 4;

__host__ __device__ __forceinline__ int lds_byte(int r, int c) { const int st = (r >> 4) * 2 + (c >> 5), rr = r & 15, cc = c & 31, ob = rr * 64 + cc * 2; return st * 1024 + (ob ^ (((ob >> 9) & 1) << 5)); }
__host__ __device__ __forceinline__ void stage_rc(int b, int& R, int& C) { const int st = b / 1024, sb = b % 1024, swz = sb ^ (((sb >> 9) & 1) << 5); R = (st >> 1) * 16 + swz / 64; C = (st & 1) * 32 + (swz % 64) / 2; }
__host__ __device__ __forceinline__ int perm32(int rho) { const int n = rho >> 4, i = rho & 15; return 8 * (i >> 2) + 4 * n + (i & 3); }

struct Unit { int pm, pn; };
struct Gemm { const bf16_t* A; const bf16_t* Bt; int M, N, K, ld, tiledA, tiledB; };

struct StaticOrder {
    int nM, nN, nwg, G, c;
    __host__ __device__ __forceinline__ void init(int M, int N, int G_, int c_) { nM = M / BM; nN = N / BM; nwg = nM * nN; G = G_; c = c_; }
    __host__ __device__ __forceinline__ bool next(int i, Unit& u) const {
        const long L = (long)i * G + c; if (L >= nwg) return false;
        int wgid = (int)L; { const int q = nwg / NXCD, r = nwg % NXCD, xcd = wgid % NXCD, off = wgid / NXCD; wgid = (xcd < r ? xcd * (q + 1) : r * (q + 1) + (xcd - r) * q) + off; }
        const int nig = WGM * nN, gid = wgid / nig, fm = gid * WGM, gsz = (nM - fm) < WGM ? (nM - fm) : WGM;
        u.pm = fm + ((wgid % nig) % gsz); u.pn = (wgid % nig) / gsz; return true;
    }
    __device__ __forceinline__ void a_ready(const Unit&) const {}
    __device__ __forceinline__ void done(const Unit&) const {}
};
struct CmpOrder {
    int c;
    __device__ __forceinline__ bool next(int i, Unit& u) const { if (i != 0 || c >= 16) return false; u.pm = c; u.pn = c >> 3; return true; }
    __device__ __forceinline__ void a_ready(const Unit&) const {}
    __device__ __forceinline__ void done(const Unit&) const {}
};

__device__ __forceinline__ unsigned cvt_pk_bf16(float lo, float hi) { unsigned r; asm volatile("v_cvt_pk_bf16_f32 %0, %1, %2" : "=v"(r) : "v"(lo), "v"(hi)); return r; }
__device__ __forceinline__ float silu_f(float x) { return x * __builtin_amdgcn_rcpf(1.0f + __builtin_amdgcn_exp2f(-1.4426950408889634f * x)); }
__device__ __forceinline__ float sigmoid_f(float x) { return __builtin_amdgcn_rcpf(1.0f + __builtin_amdgcn_exp2f(-1.4426950408889634f * x)); }


struct RowScale {
    const PG8_LAS float* rs; int pm0; const float* part; float inv_n, eps;
    __device__ __forceinline__ float get(const Unit& u, int lr) const {
        if (u.pm == pm0) return rs[lr];
        const f32x4* p = (const f32x4*)(part + ((size_t)u.pm * BM + lr) * 64); f32x4 a = p[0];
        for (int i = 1; i < 16; ++i) a += p[i];
        return 1.0f / sqrtf(((a[0] + a[1]) + (a[2] + a[3])) * inv_n + eps);
    }
};
struct EpiSwiGLU {
    static constexpr bool PERM = true, AFTER_DRAIN = false;
    bf16_t* O; int ldc; RowScale R;
    __device__ __forceinline__ void operator()(const f32x4 (&acc)[2][2][4][2], const Unit& u, int wr, int wc, int fr, int fq) const {
        const int row0 = u.pm * BM + wr * 64 + fr, col0 = u.pn * HALF + wc * 32 + 8 * fq;
#pragma unroll
        for (int ai = 0; ai < 2; ++ai)
#pragma unroll
            for (int m = 0; m < 4; ++m) { bf16_t* rowp = O + ((size_t)(col0 >> 6) * ldc + (row0 + ai * HALF + m * 16)) * 64 + (col0 & 63);
                const float rsc = R.get(u, wr * 64 + fr + ai * HALF + m * 16);
                const f32x4 g0 = acc[ai][0][m][0] * rsc, g1 = acc[ai][0][m][1] * rsc, u0 = acc[ai][1][m][0] * rsc, u1 = acc[ai][1][m][1] * rsc;
                f32x4 h0, h1;
#pragma unroll
                for (int e = 0; e < 4; ++e) { h0[e] = silu_f(g0[e]) * u0[e]; h1[e] = silu_f(g1[e]) * u1[e]; }
                u32x4 w; w.x = cvt_pk_bf16(h0[0], h0[1]); w.y = cvt_pk_bf16(h0[2], h0[3]); w.z = cvt_pk_bf16(h1[0], h1[1]); w.w = cvt_pk_bf16(h1[2], h1[3]);
                *(u32x4*)rowp = w; }
    }
};
template <bool BASE_F32> struct EpiResid {
    static constexpr bool PERM = true, AFTER_DRAIN = false;
    const void* base; bf16_t* out; int ldc; float alpha; float* part;
    __device__ __forceinline__ void operator()(const f32x4 (&acc)[2][2][4][2], const Unit& u, int wr, int wc, int fr, int fq) const {
        const int row0 = u.pm * BM + wr * 64 + fr, col0 = u.pn * BM + wc * 32 + 8 * fq;
#pragma unroll
        for (int ai = 0; ai < 2; ++ai) {
            f32x4 b0[4][2], b1[4][2];
#pragma unroll
            for (int m = 0; m < 4; ++m) { const size_t off = (size_t)(row0 + ai * HALF + m * 16) * ldc + col0;
#pragma unroll
                for (int bj = 0; bj < 2; ++bj) {
                    if constexpr (BASE_F32) { const float* bp = (const float*)base + off + bj * HALF; b0[m][bj] = *(const f32x4*)bp; b1[m][bj] = *(const f32x4*)(bp + 4); }
                    else { const u32x4 w = *(const u32x4*)((const bf16_t*)base + off + bj * HALF);
                        b0[m][bj] = (f32x4){__builtin_bit_cast(float, w.x << 16), __builtin_bit_cast(float, w.x & 0xffff0000u), __builtin_bit_cast(float, w.y << 16), __builtin_bit_cast(float, w.y & 0xffff0000u)};
                        b1[m][bj] = (f32x4){__builtin_bit_cast(float, w.z << 16), __builtin_bit_cast(float, w.z & 0xffff0000u), __builtin_bit_cast(float, w.w << 16), __builtin_bit_cast(float, w.w & 0xffff0000u)}; } } }
#pragma unroll
            for (int m = 0; m < 4; ++m) { const int row = row0 + ai * HALF + m * 16; const size_t off = (size_t)row * ldc + col0; float ss = 0.f;
#pragma unroll
                for (int bj = 0; bj < 2; ++bj) { const f32x4 v0 = b0[m][bj] + acc[ai][bj][m][0] * alpha, v1 = b1[m][bj] + acc[ai][bj][m][1] * alpha;
                    u32x4 w; w.x = cvt_pk_bf16(v0[0], v0[1]); w.y = cvt_pk_bf16(v0[2], v0[3]); w.z = cvt_pk_bf16(v1[0], v1[1]); w.w = cvt_pk_bf16(v1[2], v1[3]);
                    *(u32x4*)(out + off + bj * HALF) = w;
#pragma unroll
                    for (int e = 0; e < 4; ++e) { const unsigned ww = e == 0 ? w.x : e == 1 ? w.y : e == 2 ? w.z : w.w; const float lo = __builtin_bit_cast(float, ww << 16), hi = __builtin_bit_cast(float, ww & 0xffff0000u); ss += lo * lo + hi * hi; } }
                if (part) { ss += __shfl_xor(ss, 16); ss += __shfl_xor(ss, 32); if (fq == 0) part[(size_t)row * 64 + u.pn * 4 + wc] = ss; } }
            asm volatile("" ::: "memory"); }
    }
};
struct EpiProj {
    static constexpr bool PERM = true, AFTER_DRAIN = false;
    bf16_t* O; int ldc; int sp_pn; float* side; int side_ld; int side_n; int side_sig; RowScale R;
    __device__ __forceinline__ void operator()(const f32x4 (&acc)[2][2][4][2], const Unit& u, int wr, int wc, int fr, int fq) const {
        const int row0 = u.pm * BM + wr * 64 + fr, col0 = u.pn * BM + wc * 32 + 8 * fq;
        if (u.pn == sp_pn) {
#pragma unroll
            for (int ai = 0; ai < 2; ++ai)
#pragma unroll
                for (int m = 0; m < 4; ++m) { const int row = row0 + ai * HALF + m * 16; const float rsc = R.get(u, wr * 64 + fr + ai * HALF + m * 16);
#pragma unroll
                    for (int bj = 0; bj < 2; ++bj) { const int cl = bj * HALF + wc * 32 + 8 * fq;
                        if (cl < side_n) { f32x4 v0 = acc[ai][bj][m][0] * rsc, v1 = acc[ai][bj][m][1] * rsc;
                            if (side_sig) {
#pragma unroll
                                for (int e = 0; e < 4; ++e) { v0[e] = sigmoid_f(v0[e]); v1[e] = sigmoid_f(v1[e]); } }
                            float* sp = side + (size_t)row * side_ld + cl; *(f32x4*)sp = v0; *(f32x4*)(sp + 4) = v1; } } }
            return;
        }
#pragma unroll
        for (int ai = 0; ai < 2; ++ai)
#pragma unroll
            for (int m = 0; m < 4; ++m) { bf16_t* rowp = O + (size_t)(row0 + ai * HALF + m * 16) * ldc + col0; const float rsc = R.get(u, wr * 64 + fr + ai * HALF + m * 16);
#pragma unroll
                for (int bj = 0; bj < 2; ++bj) { const f32x4 v0 = acc[ai][bj][m][0] * rsc, v1 = acc[ai][bj][m][1] * rsc;
                    u32x4 w; w.x = cvt_pk_bf16(v0[0], v0[1]); w.y = cvt_pk_bf16(v0[2], v0[3]); w.z = cvt_pk_bf16(v1[0], v1[1]); w.w = cvt_pk_bf16(v1[2], v1[3]);
                    *(u32x4*)(rowp + bj * HALF) = w; } }
    }
};
struct EpiCmp {
    static constexpr bool PERM = true, AFTER_DRAIN = false;
    bf16_t* O; const float* bias;
    __device__ __forceinline__ void operator()(const f32x4 (&acc)[2][2][4][2], const Unit& u, int wr, int wc, int fr, int fq) const {
        const int row0 = u.pm * BM + wr * 64 + fr, cl0 = wc * 32 + 8 * fq;
        f32x4 bv[2][2];
#pragma unroll
        for (int bj = 0; bj < 2; ++bj)
#pragma unroll
            for (int n = 0; n < 2; ++n) bv[bj][n] = *(const f32x4*)(bias + u.pn * BM + cl0 + bj * HALF + 4 * n);
#pragma unroll
        for (int ai = 0; ai < 2; ++ai)
#pragma unroll
            for (int m = 0; m < 4; ++m) { bf16_t* rowp = O + (size_t)(row0 + ai * HALF + m * 16) * 256 + cl0;
#pragma unroll
                for (int bj = 0; bj < 2; ++bj) { f32x4 v0 = acc[ai][bj][m][0] + bv[bj][0], v1 = acc[ai][bj][m][1] + bv[bj][1];
#pragma unroll
                    for (int e = 0; e < 4; ++e) { v0[e] = silu_f(v0[e]); v1[e] = silu_f(v1[e]); }
                    u32x4 w; w.x = cvt_pk_bf16(v0[0], v0[1]); w.y = cvt_pk_bf16(v0[2], v0[3]); w.z = cvt_pk_bf16(v1[0], v1[1]); w.w = cvt_pk_bf16(v1[2], v1[3]);
                    *(u32x4*)(rowp + bj * HALF) = w; } }
    }
};

template <class Epi, class Sched, bool ALIGN_EPI = false, bool SP2 = false>
__device__ __forceinline__ void gemm_phase(PG8_LAS unsigned char* lds, const Gemm g, const Sched& S, const Epi& E) {
    int tid_ = threadIdx.x; asm volatile("" : "+v"(tid_));
    const int tid = tid_, wid = __builtin_amdgcn_readfirstlane(tid >> 6), lane = tid & 63, wr = wid >> 2, wc = wid & 3, fr = lane & 15, fq = lane >> 4;
    const int K = g.ld, nt = g.K / BK;
    const unsigned rpA = g.tiledA ? 128u : (unsigned)K * 2u, rpB = g.tiledB ? 128u : (unsigned)K * 2u;
    unsigned voffA[2], voffB[2];
#pragma unroll
    for (int i = 0; i < 2; ++i) { int R, C; stage_rc(tid * 16 + i * 8192, R, C); const int Rb = Epi::PERM ? ((R & ~31) + perm32(R & 31)) : R;
        voffA[i] = (unsigned)R * rpA + (unsigned)C * 2u; voffB[i] = (unsigned)Rb * rpB + (unsigned)C * 2u; }
    const size_t kstepA = g.tiledA ? (size_t)g.M * 128 : (size_t)(BK * 2), kstepB = g.tiledB ? (size_t)g.N * 128 : (size_t)(BK * 2);
    const size_t hstepA = (size_t)HALF * rpA, hstepB = (size_t)HALF * rpB;
    const size_t tstepA = 2 * hstepA, tstepB = 2 * hstepB;
    const unsigned ldsw = (unsigned)wid * 1024u;
    const int aoff = lds_byte(wr * 64 + fr, fq * 8), boff = lds_byte(wc * 32 + fr, fq * 8);
#define PG8_SA(b, h) (((b) * 2 + (h)) * HTB)
#define PG8_SB(b, h) ((4 + (b) * 2 + (h)) * HTB)
#define PG8_STAGE(bufoff, gbase, voff) do { _Pragma("unroll") for (int _i = 0; _i < 2; ++_i) \
        __builtin_amdgcn_global_load_lds((const unsigned*)((const char*)(gbase) + (voff)[_i]), (PG8_LAS unsigned*)(lds + (bufoff) + ldsw + _i * 8192), 16, 0, 0); } while (0)
#define PG8_LDA(dst, b, h) do { _Pragma("unroll") for (int m = 0; m < 4; ++m) _Pragma("unroll") for (int k = 0; k < 2; ++k) dst[m][k] = *(const PG8_LAS bf16x8*)(lds + PG8_SA(b, h) + aoff + m * 2048 + k * 1024); } while (0)
#define PG8_LDB(dst, b, h) do { _Pragma("unroll") for (int n = 0; n < 2; ++n) _Pragma("unroll") for (int k = 0; k < 2; ++k) dst[n][k] = *(const PG8_LAS bf16x8*)(lds + PG8_SB(b, h) + boff + n * 2048 + k * 1024); } while (0)
#define PG8_MMA(ai, bj, At, Bt) do { __builtin_amdgcn_s_setprio(1); _Pragma("unroll") for (int m = 0; m < 4; ++m) _Pragma("unroll") for (int n = 0; n < 2; ++n) _Pragma("unroll") for (int k = 0; k < 2; ++k) \
        acc[ai][bj][m][n] = __builtin_amdgcn_mfma_f32_16x16x32_bf16(Bt[n][k], At[m][k], acc[ai][bj][m][n], 0, 0, 0); __builtin_amdgcn_s_setprio(0); } while (0)
#define PG8_WAIT_V(n) asm volatile("s_waitcnt vmcnt(" #n ")" ::: "memory")
#define PG8_WAIT_L(n) asm volatile("s_waitcnt lgkmcnt(" #n ")" ::: "memory")
#define PG8_BAR __builtin_amdgcn_s_barrier()
#define PG8_SCHED __builtin_amdgcn_sched_barrier(0)
    Unit cur, nxt; int ui = 0;
    if (!S.next(0, cur)) return;
    f32x4 acc[2][2][4][2];
#pragma unroll
    for (int a = 0; a < 2; ++a)
#pragma unroll
        for (int b = 0; b < 2; ++b)
#pragma unroll
            for (int m = 0; m < 4; ++m)
#pragma unroll
                for (int n = 0; n < 2; ++n) acc[a][b][m][n] = (f32x4){0.f, 0.f, 0.f, 0.f};
    bf16x8 At[4][2], B0[2][2], B1[2][2];
    const char* cA = (const char*)g.A + (size_t)cur.pm * tstepA; const char* cB = (const char*)g.Bt + (size_t)cur.pn * tstepB;
    S.a_ready(cur);
    if constexpr (SP2) {
        PG8_STAGE(PG8_SB(0, 0), cB, voffB); PG8_STAGE(PG8_SB(0, 1), cB + hstepB, voffB); PG8_STAGE(PG8_SA(0, 0), cA, voffA); PG8_STAGE(PG8_SA(0, 1), cA + hstepA, voffA);
        if (wr == 1) PG8_BAR;
        PG8_WAIT_V(2); PG8_BAR;
        PG8_STAGE(PG8_SB(1, 0), cB + kstepB, voffB); PG8_STAGE(PG8_SA(1, 0), cA + kstepA, voffA); PG8_STAGE(PG8_SB(1, 1), cB + hstepB + kstepB, voffB);
        PG8_WAIT_V(6); PG8_BAR;
    } else {
        PG8_STAGE(PG8_SB(0, 0), cB, voffB); PG8_STAGE(PG8_SA(0, 0), cA, voffA); PG8_STAGE(PG8_SB(0, 1), cB + hstepB, voffB); PG8_STAGE(PG8_SA(0, 1), cA + hstepA, voffA);
        if (wr == 1) PG8_BAR;
        PG8_WAIT_V(4); PG8_BAR;
        PG8_STAGE(PG8_SB(1, 0), cB + kstepB, voffB); PG8_STAGE(PG8_SA(1, 0), cA + kstepA, voffA); PG8_STAGE(PG8_SB(1, 1), cB + hstepB + kstepB, voffB);
        PG8_WAIT_V(6); PG8_BAR;
    }
    for (;;) {
        const bool has_next = S.next(ui + 1, nxt);
        const char* nA = has_next ? (const char*)g.A + (size_t)nxt.pm * tstepA : cA; const char* nB = has_next ? (const char*)g.Bt + (size_t)nxt.pn * tstepB : cB;
        for (int t = 0; t < nt; t += 2) {
            const bool last = (t == nt - 2);
            const char* a1 = cA + (size_t)(t + 1) * kstepA;
            const char* a2 = last ? nA : cA + (size_t)(t + 2) * kstepA; const char* b2 = last ? nB : cB + (size_t)(t + 2) * kstepB;
            const char* a3 = a2 + kstepA; const char* b3 = b2 + kstepB;
            if (last && has_next) S.a_ready(nxt);
            if constexpr (SP2) {
            PG8_LDB(B0, 0, 0); PG8_LDB(B1, 0, 1); PG8_SCHED; PG8_LDA(At, 0, 0); PG8_STAGE(PG8_SA(1, 1), a1 + hstepA, voffA);
            PG8_WAIT_V(8); PG8_WAIT_L(0); PG8_BAR; PG8_MMA(0, 0, At, B0); PG8_MMA(0, 1, At, B1); PG8_BAR; PG8_SCHED;
            PG8_LDA(At, 0, 1); PG8_STAGE(PG8_SB(0, 0), b2, voffB); PG8_STAGE(PG8_SB(0, 1), b2 + hstepB, voffB); PG8_STAGE(PG8_SA(0, 0), a2, voffA);
            PG8_WAIT_V(8); PG8_WAIT_L(0); PG8_BAR; PG8_MMA(1, 0, At, B0); PG8_MMA(1, 1, At, B1); PG8_BAR; PG8_SCHED;
            PG8_LDB(B0, 1, 0); PG8_LDB(B1, 1, 1); PG8_SCHED; PG8_LDA(At, 1, 0); PG8_STAGE(PG8_SA(0, 1), a2 + hstepA, voffA);
            PG8_WAIT_V(8); PG8_WAIT_L(0); PG8_BAR; PG8_MMA(0, 0, At, B0); PG8_MMA(0, 1, At, B1); PG8_BAR; PG8_SCHED;
            PG8_LDA(At, 1, 1); PG8_STAGE(PG8_SB(1, 0), b3, voffB); PG8_STAGE(PG8_SB(1, 1), b3 + hstepB, voffB); PG8_STAGE(PG8_SA(1, 0), a3, voffA);
            PG8_WAIT_V(8); PG8_WAIT_L(0); PG8_BAR; PG8_MMA(1, 0, At, B0); PG8_MMA(1, 1, At, B1); PG8_BAR; PG8_SCHED;
            } else {
            PG8_LDB(B0, 0, 0); PG8_SCHED; PG8_LDA(At, 0, 0); PG8_STAGE(PG8_SA(1, 1), a1 + hstepA, voffA);
            PG8_WAIT_L(8); PG8_BAR; PG8_WAIT_L(0); PG8_MMA(0, 0, At, B0); PG8_BAR; PG8_SCHED;
            PG8_LDB(B1, 0, 1); PG8_STAGE(PG8_SB(0, 0), b2, voffB);
            PG8_BAR; PG8_WAIT_L(0); PG8_MMA(0, 1, At, B1); PG8_BAR;
            PG8_LDA(At, 0, 1); PG8_STAGE(PG8_SA(0, 0), a2, voffA);
            PG8_BAR; PG8_WAIT_L(0); PG8_MMA(1, 0, At, B0); PG8_BAR; PG8_SCHED;
            PG8_STAGE(PG8_SB(0, 1), b2 + hstepB, voffB);
            PG8_WAIT_V(6); PG8_BAR; PG8_MMA(1, 1, At, B1); PG8_BAR;
            PG8_LDB(B0, 1, 0); PG8_SCHED; PG8_LDA(At, 1, 0); PG8_STAGE(PG8_SA(0, 1), a2 + hstepA, voffA);
            PG8_WAIT_L(8); PG8_BAR; PG8_WAIT_L(0); PG8_MMA(0, 0, At, B0); PG8_BAR; PG8_SCHED;
            PG8_LDB(B1, 1, 1); PG8_STAGE(PG8_SB(1, 0), b3, voffB);
            PG8_BAR; PG8_WAIT_L(0); PG8_MMA(0, 1, At, B1); PG8_BAR;
            PG8_LDA(At, 1, 1); PG8_STAGE(PG8_SA(1, 0), a3, voffA);
            PG8_BAR; PG8_WAIT_L(0); PG8_MMA(1, 0, At, B0); PG8_BAR; PG8_SCHED;
            PG8_STAGE(PG8_SB(1, 1), b3 + hstepB, voffB);
            PG8_WAIT_V(6); PG8_BAR; PG8_MMA(1, 1, At, B1); PG8_BAR;
            }
        }
        if constexpr (ALIGN_EPI) { if (wr == 0) PG8_BAR; }
        if constexpr (!Epi::AFTER_DRAIN) { E(acc, cur, wr, wc, fr, fq); S.done(cur); }
        if (!has_next) break;
#pragma unroll
        for (int a = 0; a < 2; ++a)
#pragma unroll
            for (int b = 0; b < 2; ++b)
#pragma unroll
                for (int m = 0; m < 4; ++m)
#pragma unroll
                    for (int n = 0; n < 2; ++n) acc[a][b][m][n] = (f32x4){0.f, 0.f, 0.f, 0.f};
        cur = nxt; cA = nA; cB = nB; ++ui;
        if constexpr (ALIGN_EPI) { if (wr == 1) PG8_BAR; }
    }
    PG8_WAIT_V(0);
    if constexpr (!ALIGN_EPI) { if (wr == 0) PG8_BAR; }
    PG8_BAR;
    if constexpr (Epi::AFTER_DRAIN) { E.fused(acc, cur, wr, wc, fr, fq, lds, wid, lane); S.done(cur); }
#undef PG8_SA
#undef PG8_SB
#undef PG8_STAGE
#undef PG8_LDA
#undef PG8_LDB
#undef PG8_MMA
#undef PG8_WAIT_V
#undef PG8_WAIT_L
#undef PG8_BAR
#undef PG8_SCHED
}
}

#define XB_TMO      128
#define XB_XCNT(j)  (256  + 64 * (j))
#define XB_XSUB(j)  (1280 + 64 * (j))
#define XB_XGEN(j)  (2304 + 64 * (j))
#define XB_TOP      3328
#define XB_TOPGEN   3392
#define XCD_BAR_WORDS 3456
#define XB_SPIN_CAP (1u << 18)
#define LAS __attribute__((address_space(3)))

__device__ __forceinline__ unsigned xb_ld(unsigned* p)              { return __hip_atomic_load(p, __ATOMIC_RELAXED, __HIP_MEMORY_SCOPE_AGENT); }
__device__ __forceinline__ unsigned xb_add(unsigned* p, unsigned v) { return __hip_atomic_fetch_add(p, v, __ATOMIC_RELAXED, __HIP_MEMORY_SCOPE_AGENT); }
__device__ __forceinline__ unsigned xb_xcc_id() { return (unsigned)__builtin_amdgcn_s_getreg((3 << 11) | 20) & 0xFu; }
#define XB_SPIN(cond, bar) do { unsigned _sp = 0; while (cond) { __builtin_amdgcn_s_sleep(1); \
    if ((++_sp & 255u) == 0u) { if (xb_ld(&(bar)[XB_TMO])) break; if (_sp > XB_SPIN_CAP) { atomicAdd(&(bar)[XB_TMO], 1u); break; } } } } while (0)

struct XcdBarrier {
    unsigned* bar; unsigned x;
    volatile LAS unsigned* st;
};
__device__ __forceinline__ XcdBarrier xcd_barrier_post(unsigned* bar, volatile LAS unsigned* st) {
    XcdBarrier b; b.bar = bar; b.x = xb_xcc_id(); b.st = st;
    if (threadIdx.x == 0) (void)xb_add(&bar[XB_XCNT(b.x)], 1u);
    return b;
}
__device__ __forceinline__ void xcd_barrier_complete(unsigned* bar, unsigned x, unsigned& nloc, unsigned& nx) {
    const unsigned G = gridDim.x * gridDim.y * gridDim.z;
    unsigned sum, cnt, mine, sp = 0u;
    for (;;) {
        sum = 0u; cnt = 0u; mine = 0u;
#pragma unroll
        for (unsigned j = 0; j < 16; ++j) { const unsigned c = xb_ld(&bar[XB_XCNT(j)]); sum += c; cnt += (c > 0u) ? 1u : 0u; mine = (j == x) ? c : mine; }
        if (sum == G) break;
        __builtin_amdgcn_s_sleep(1);
        if ((++sp & 255u) == 0u) { if (xb_ld(&bar[XB_TMO])) break; if (sp > XB_SPIN_CAP) { atomicAdd(&bar[XB_TMO], 1u); break; } }
    }
    nloc = mine > 0u ? mine : 1u; nx = cnt > 0u ? cnt : 1u;
}
__device__ __forceinline__ void xcd_barrier(const XcdBarrier& b) {
    asm volatile("s_waitcnt vmcnt(0)" ::: "memory");
    __syncthreads();
    if (threadIdx.x == 0) {
        unsigned* bar = b.bar;
        __builtin_amdgcn_s_waitcnt(0);
        unsigned nloc = b.st[0], nx = b.st[1];
        if (nloc == 0u) { xcd_barrier_complete(bar, b.x, nloc, nx); b.st[0] = nloc; b.st[1] = nx; }
        const unsigned old = xb_add(&bar[XB_XSUB(b.x)], 1u);
        const unsigned gen = old / nloc;
        if (old + 1u == (gen + 1u) * nloc) {
            __builtin_amdgcn_fence(__ATOMIC_RELEASE, "agent");
            asm volatile("s_waitcnt vmcnt(0)" ::: "memory");
            const unsigned og = xb_add(&bar[XB_TOP], 1u);
            const unsigned tg = og / nx;
            if (og + 1u == (tg + 1u) * nx) xb_add(&bar[XB_TOPGEN], 1u);
            else XB_SPIN(xb_ld(&bar[XB_TOPGEN]) == tg, bar);
            __builtin_amdgcn_fence(__ATOMIC_ACQUIRE, "agent");
            xb_add(&bar[XB_XGEN(b.x)], 1u);
            asm volatile("s_waitcnt vmcnt(0)" ::: "memory");
        } else {
            XB_SPIN(xb_ld(&bar[XB_XGEN(b.x)]) == gen, bar);
            __builtin_amdgcn_fence(__ATOMIC_ACQUIRE, "agent");
            asm volatile("s_waitcnt vmcnt(0)" ::: "memory");
        }
    }
    __syncthreads();
}

namespace att {
enum { ORDER_PAIRED = 2 };
constexpr int HD = 128;
constexpr float THR = 8.f;
constexpr float SCALE = 0.08838834764831845f;
constexpr float ISCALE = 11.313708498984761f;
constexpr int NW = 8, QBLK = 32, KVBLK = 64, QB = NW * QBLK;
constexpr int SHM_V = KVBLK * HD * 2, SHM_K = KVBLK * HD * 2;
constexpr int LDS_BYTES = 2 * SHM_V + 2 * SHM_K + NW * 64 * 4;
using bf16 = __hip_bfloat16;
typedef short bf16x8 __attribute__((ext_vector_type(8)));
typedef short s16x4 __attribute__((ext_vector_type(4)));
typedef float f32x16 __attribute__((ext_vector_type(16)));
typedef float f32x4 __attribute__((ext_vector_type(4)));
typedef unsigned u32x4 __attribute__((ext_vector_type(4)));
template <class A, class Bt> struct same_t { static constexpr bool v = false; };
template <class A> struct same_t<A, A> { static constexpr bool v = true; };

#define KSWZ(row, colB) ((row) * 256 + ((colB) ^ (((row) & 7) << 4)))
#define SBAR() __builtin_amdgcn_sched_barrier(0)
__device__ __forceinline__ int v_st(int k, int c) { const int kk = (k & ~0xC) | ((k & 4) << 1) | ((k & 8) >> 1); return ((kk >> 3) * 4 + (c >> 5)) * 512 + ((kk & 7) * 32 + (c & 31)) * 2; }
__device__ __forceinline__ int v_rd_base(int lane) { return ((lane & 3) << 3) | (((lane >> 2) & 3) << 6) | (((lane >> 4) & 1) << 5) | (((lane >> 5) & 1) << 8); }
constexpr int v_rd_off(int d0, int ks, int half) { return d0 * 512 + ks * 4096 + half * 2048; }
__device__ __forceinline__ int crow(int r, int hi) { return (r & 3) + 8 * (r >> 2) + 4 * hi; }
__device__ __forceinline__ unsigned cvtpk(float lo, float hi) {
    unsigned r; asm volatile("v_cvt_pk_bf16_f32 %0, %1, %2" : "=v"(r) : "v"(lo), "v"(hi)); return r;
}
__device__ __forceinline__ bf16x8 load8(const bf16* p) { return *reinterpret_cast<const bf16x8*>(p); }
__device__ __forceinline__ void mask_tile(f32x16& p0, f32x16& p1, int dq, unsigned W) {
    const float NEG = -__builtin_inff();
#pragma unroll
    for (int r = 0; r < 16; ++r) {
        const int c = (r & 3) + 8 * (r >> 2);
        if ((unsigned)(dq - c) >= W) p0[r] = NEG;
        if ((unsigned)(dq - c - 32) >= W) p1[r] = NEG;
    }
}
__device__ __forceinline__ void fox_bias(f32x16& p0, f32x16& p1, float cq, const float* ck) {
#pragma unroll
    for (int g = 0; g < 4; ++g) { const f32x4 c0 = *(const f32x4*)(ck + 8 * g), c1 = *(const f32x4*)(ck + 32 + 8 * g);
#pragma unroll
        for (int e = 0; e < 4; ++e) { p0[4 * g + e] += (cq - c0[e]) * ISCALE; p1[4 * g + e] += (cq - c1[e]) * ISCALE; } }
}
__device__ __forceinline__ void partialSM(f32x16& p0, f32x16& p1, float& m_reg, float& mn, float& alpha) {
    float pmax = p0[0]; for (int r = 1; r < 16; ++r) pmax = fmaxf(pmax, p0[r]); for (int r = 0; r < 16; ++r) pmax = fmaxf(pmax, p1[r]);
    { auto rr = __builtin_amdgcn_permlane32_swap(__float_as_uint(pmax), __float_as_uint(pmax), false, false);
      pmax = fmaxf(__uint_as_float(rr[0]), __uint_as_float(rr[1])); }
    constexpr float C2 = 1.4426950408889634f * SCALE;
    if (__builtin_expect(__all((pmax - m_reg) * SCALE <= THR), 1)) { mn = m_reg; alpha = 1.f; }
    else { mn = fmaxf(m_reg, pmax); alpha = __builtin_amdgcn_exp2f((m_reg - mn) * C2); m_reg = mn; }
    const float mnL = -mn * C2;
    for (int r = 0; r < 16; ++r) p0[r] = fmaf(p0[r], C2, mnL); for (int r = 0; r < 16; ++r) p1[r] = fmaf(p1[r], C2, mnL);
    for (int r = 0; r < 16; ++r) p0[r] = __builtin_amdgcn_exp2f(p0[r]);
}
#define PK4(P, B_, OUT) do { unsigned a0 = cvtpk(P[B_+0], P[B_+1]), a1 = cvtpk(P[B_+2], P[B_+3]);                          \
        unsigned b0 = cvtpk(P[B_+4], P[B_+5]), b1 = cvtpk(P[B_+6], P[B_+7]);                                             \
        auto r0 = __builtin_amdgcn_permlane32_swap(a0, b0, false, false); auto r1 = __builtin_amdgcn_permlane32_swap(a1, b1, false, false); \
        u32x4 w = {r0[0], r1[0], r0[1], r1[1]}; OUT = *reinterpret_cast<bf16x8*>(&w); } while (0)
__device__ __forceinline__ void finishSM(f32x16& p0, f32x16& p1, float alpha, float& l_reg, bf16x8& pa0, bf16x8& pa1, bf16x8& pa2, bf16x8& pa3) {
    for (int r = 0; r < 16; ++r) p1[r] = __builtin_amdgcn_exp2f(p1[r]);
    float ps = 0; for (int r = 0; r < 16; ++r) ps += p0[r]; for (int r = 0; r < 16; ++r) ps += p1[r];
    { auto rr = __builtin_amdgcn_permlane32_swap(__float_as_uint(ps), __float_as_uint(ps), false, false);
      ps = __uint_as_float(rr[0]) + __uint_as_float(rr[1]); }
    l_reg = l_reg * alpha + ps;
    PK4(p0, 0, pa0); PK4(p0, 8, pa1); PK4(p1, 0, pa2); PK4(p1, 8, pa3);
}
template <int KB, bool SK>
__device__ __forceinline__ void qkt(f32x16& p0, f32x16& p1, const char* K_lds, int r32, int hi, const bf16x8* qr, bool act) {
    if (SK && !act) { const float NEG = -__builtin_inff();
#pragma unroll
        for (int r = 0; r < 16; ++r) { p0[r] = NEG; p1[r] = NEG; } return; }
    p0 = f32x16{}; p1 = f32x16{};
    const char* kb[4];
#pragma unroll
    for (int dd = 0; dd < 4; ++dd) kb[dd] = K_lds + KB * SHM_K + KSWZ(r32, (dd * 16 + hi * 8) * 2);
#pragma unroll
    for (int d0 = 0; d0 < 8; ++d0) { const char* a = kb[d0 & 3] + (d0 >> 2) * 128;
        bf16x8 b0 = *reinterpret_cast<const bf16x8*>(a);
        bf16x8 b1 = *reinterpret_cast<const bf16x8*>(a + 32 * 256);
        p0 = __builtin_amdgcn_mfma_f32_32x32x16_bf16(b0, qr[d0], p0, 0, 0, 0);
        p1 = __builtin_amdgcn_mfma_f32_32x32x16_bf16(b1, qr[d0], p1, 0, 0, 0); }
}
template <int VB, bool SK>
__device__ __forceinline__ void pv_tile(f32x16* o, int vb0, bf16x8 pa0, bf16x8 pa1, bf16x8 pa2, bf16x8 pa3, bool act) {
    if (SK && !act) return;
#define TRRD(dst, off) asm volatile("ds_read_b64_tr_b16 %0, %1 offset:%2" : "=&v"(dst) : "v"(vb0), "i"(off) : "memory")
#define PV_D0(d0) do { s16x4 l0, l1, l2, l3, h0, h1, h2, h3; constexpr int b_ = VB * SHM_V + v_rd_off(d0, 0, 0);   \
        TRRD(l0, b_); TRRD(h0, b_ + 2048); TRRD(l1, b_ + 4096); TRRD(h1, b_ + 6144); TRRD(l2, b_ + 8192); TRRD(h2, b_ + 10240); TRRD(l3, b_ + 12288); TRRD(h3, b_ + 14336); \
        asm volatile("s_waitcnt lgkmcnt(0)" ::: "memory"); SBAR();   \
        o[d0] = __builtin_amdgcn_mfma_f32_32x32x16_bf16(pa0, (bf16x8){l0[0], l0[1], l0[2], l0[3], h0[0], h0[1], h0[2], h0[3]}, o[d0], 0, 0, 0);   \
        o[d0] = __builtin_amdgcn_mfma_f32_32x32x16_bf16(pa1, (bf16x8){l1[0], l1[1], l1[2], l1[3], h1[0], h1[1], h1[2], h1[3]}, o[d0], 0, 0, 0);   \
        o[d0] = __builtin_amdgcn_mfma_f32_32x32x16_bf16(pa2, (bf16x8){l2[0], l2[1], l2[2], l2[3], h2[0], h2[1], h2[2], h2[3]}, o[d0], 0, 0, 0);   \
        o[d0] = __builtin_amdgcn_mfma_f32_32x32x16_bf16(pa3, (bf16x8){l3[0], l3[1], l3[2], l3[3], h3[0], h3[1], h3[2], h3[3]}, o[d0], 0, 0, 0); } while (0)
    PV_D0(0); PV_D0(1); PV_D0(2); PV_D0(3);
#undef PV_D0
#undef TRRD
}

template <class TOut> struct BlockRef { const bf16* Q; const bf16* K; const bf16* V; TOut* O; const void* X; const void* Y; const void* Z; int P0; int J0; };
struct Seam { bf16x8 qr[8]; bf16x8 st_v0, st_v1, st_k0, st_k1; };
__device__ __forceinline__ int swa_jlo(int P0, int W) { const int lowk = P0 - W + 1; return lowk > 0 ? lowk / KVBLK : 0; }
#define ROWK(p, k0, rr) ((p) + (size_t)((k0) + (rr)) * LDK + sc)
#define ROWV(p, k0, rr) ((p) + (size_t)((k0) + (rr)) * LDV + sc)
#define VMW() asm volatile("s_waitcnt vmcnt(0)" ::: "memory")
#define VMWN(n) asm volatile("s_waitcnt vmcnt(%0)" :: "i"(n) : "memory")
#define SLOAD_H(Kp, Vp, k0) do { S.st_v0 = load8(ROWV(Vp, k0, sr)); S.st_v1 = load8(ROWV(Vp, k0, 32 + sr));              \
                         S.st_k0 = load8(ROWK(Kp, k0, sr)); S.st_k1 = load8(ROWK(Kp, k0, 32 + sr)); } while (0)
#define SWRITE_HK(bf) do { *(bf16x8*)(K_lds + (bf) * SHM_K + kws) = S.st_k0; *(bf16x8*)(K_lds + (bf) * SHM_K + kws + 32 * 256) = S.st_k1; } while (0)
#define SWRITE_HV(bf) do { *(bf16x8*)(V_lds + (bf) * SHM_V + vst0) = S.st_v0; *(bf16x8*)(V_lds + (bf) * SHM_V + vst1) = S.st_v1; } while (0)
#define SWRITE_H(bf) do { SWRITE_HV(bf); SWRITE_HK(bf); } while (0)
template <class TOut, int LDQ, int LDK, int LDV>
__device__ __forceinline__ void attn_prime(const BlockRef<TOut>& cur, int W, char* lds, Seam& S) {
    int tid_ = threadIdx.x; asm volatile("" : "+v"(tid_));
    const int tid = tid_, wid = __builtin_amdgcn_readfirstlane(tid >> 6), lane = tid & 63, r32 = lane & 31, hi = lane >> 5;
    const int sr = tid >> 4, sc = (tid & 15) * 8, kws = KSWZ(sr, sc * 2); char* K_lds = lds + 2 * SHM_V;
    const int kb0 = (swa_jlo(cur.P0, W) > cur.J0 ? swa_jlo(cur.P0, W) : cur.J0) * KVBLK;
    for (int d0 = 0; d0 < 8; ++d0) S.qr[d0] = load8(cur.Q + (size_t)(wid * QBLK + r32) * LDQ + d0 * 16 + hi * 8);
    SLOAD_H(cur.K, cur.V, kb0); VMW(); SWRITE_HK(0);
    __syncthreads();
}
template <int MODE, bool WSKIP, class TOut, int LDQ, int LDK, int LDV, int LDO>
__device__ __forceinline__ void attn_block(const BlockRef<TOut>& cur, const BlockRef<TOut>& nxt, int skv, int W, char* lds, Seam& S) {
    int tid_ = threadIdx.x; asm volatile("" : "+v"(tid_));
    const int tid = tid_, wid = __builtin_amdgcn_readfirstlane(tid >> 6), lane = tid & 63, r32 = lane & 31, hi = lane >> 5;
    const int j_lo = swa_jlo(cur.P0, W) > cur.J0 ? swa_jlo(cur.P0, W) : cur.J0;
    int j_hi = (cur.P0 + QB - 1) / KVBLK + 1; if (j_hi > skv / KVBLK) j_hi = skv / KVBLK;
    const int NT = j_hi - j_lo;
    const int kbn = (swa_jlo(nxt.P0, W) > nxt.J0 ? swa_jlo(nxt.P0, W) : nxt.J0) * KVBLK;
    const int qlo = cur.P0 + wid * QBLK, qm = qlo + r32 - 4 * hi;
    char* V_lds = lds; char* K_lds = lds + 2 * SHM_V;
    float* ws = (float*)(lds + 2 * SHM_V + 2 * SHM_K) + wid * 64; float* li_l = ws, * al_l = ws + 32;
    float m_reg = -1e30f, l_reg = 0; f32x16 o[4] = {};
    const int sr = tid >> 4, sc = (tid & 15) * 8, vst0 = v_st(sr, sc), vst1 = v_st(32 + sr, sc), kws = KSWZ(sr, sc * 2);
    const int vb0 = (int)(uintptr_t)V_lds + v_rd_base(lane);
    const bf16* Kh = cur.K; const bf16* Vh = cur.V;
    float cq = 0.f; const float* ckb = nullptr; unsigned selm = 0xffffffffu, wor = 0xffffffffu;
    if constexpr (MODE == 1) { const float* C = (const float*)cur.X; cq = C[qlo + r32]; ckb = C + 4 * hi; }
    if constexpr (MODE == 2) { const unsigned* SMp = (const unsigned*)cur.X; selm = SMp[qlo + r32]; wor = selm;
#pragma unroll
        for (int o_ = 1; o_ < 64; o_ <<= 1) wor |= (unsigned)__shfl_xor((int)wor, o_);
        wor = (unsigned)__builtin_amdgcn_readfirstlane((int)wor); }
#define RESC(a) do { if (__any((a) < 1.f)) { if (hi == 0) al_l[r32] = (a); asm volatile("s_waitcnt lgkmcnt(0)" ::: "memory");              \
                     for (int d_ = 0; d_ < 4; ++d_) for (int r = 0; r < 16; ++r) o[d_][r] *= al_l[crow(r, hi)]; } } while (0)
#define KBASE(t) ((j_lo + (t)) * KVBLK)
#define ACT(t) (KBASE(t) <= qlo + QBLK - 1 && KBASE(t) + KVBLK - 1 >= qlo - W + 1 && (MODE != 2 || ((wor >> (j_lo + (t))) & 1u)))
#define BIAST(P0_, P1_, t) do { if constexpr (MODE == 1) fox_bias(P0_, P1_, cq, ckb + KBASE(t)); } while (0)
#define MASKT(P0_, P1_, t) do { const int kb_ = KBASE(t); \
        if constexpr (MODE == 2) { if (!SK || ACT(t)) mask_tile(P0_, P1_, ((selm >> (j_lo + (t))) & 1u) ? qm - kb_ : -1000000, (unsigned)W); } \
        else { if ((!SK || ACT(t)) && (kb_ + KVBLK - 1 > qlo || kb_ <= qlo + QBLK - 1 - W)) mask_tile(P0_, P1_, qm - kb_, (unsigned)W); } } while (0)
    constexpr int NQL = 8;
    constexpr bool SK = WSKIP;
#define SEAM_K0() do { VMWN(NQL); SWRITE_HK(0); SBAR(); } while (0)
    f32x16 pA0, pA1, pB0, pB1; float mnA, mnB, alA, alB; bf16x8 pa0, pa1, pa2, pa3;
    SWRITE_HV(0); SBAR();
    if (NT > 1) { SLOAD_H(Kh, Vh, KBASE(1)); }
    SBAR(); qkt<0, SK>(pA0, pA1, K_lds, r32, hi, S.qr, ACT(0));
    BIAST(pA0, pA1, 0); MASKT(pA0, pA1, 0); partialSM(pA0, pA1, m_reg, mnA, alA);
    if (NT > 1) { VMW(); SWRITE_H(1); }
    __syncthreads();
#define HALF_STEP(PX0, PX1, mnX, alX, PY0, PY1, alY, t, KB, VB, SB) do {                                                      \
        SBAR(); qkt<KB, SK>(PX0, PX1, K_lds, r32, hi, S.qr, ACT(t));                                             \
        finishSM(PY0, PY1, alY, l_reg, pa0, pa1, pa2, pa3); SBAR();                                                           \
        if ((t) + 1 < NT) { SLOAD_H(Kh, Vh, KBASE((t) + 1)); SBAR(); }                                               \
        pv_tile<VB, SK>(o, vb0, pa0, pa1, pa2, pa3, ACT((t) - 1)); BIAST(PX0, PX1, (t)); MASKT(PX0, PX1, (t)); partialSM(PX0, PX1, m_reg, mnX, alX);                                        \
        __syncthreads();                                                                                                      \
        if ((t) + 1 < NT) { VMW(); SWRITE_H(SB); }                                                                          \
        RESC(alX); __syncthreads(); } while (0)
    for (int t = 1; t + 1 < NT; t += 2) {
        HALF_STEP(pB0, pB1, mnB, alB, pA0, pA1, alA, t, 1, 0, 0);
        HALF_STEP(pA0, pA1, mnA, alA, pB0, pB1, alB, t + 1, 0, 1, 1);
    }
    const bool even = (NT & 1) == 0;
    if (even) { SBAR(); qkt<1, SK>(pB0, pB1, K_lds, r32, hi, S.qr, ACT(NT - 1)); SBAR(); }
    { SLOAD_H(nxt.K, nxt.V, kbn); SBAR();
#pragma unroll
        for (int d0 = 0; d0 < 8; ++d0) S.qr[d0] = load8(nxt.Q + (size_t)(wid * QBLK + r32) * LDQ + d0 * 16 + hi * 8); }
    SBAR();
    finishSM(pA0, pA1, alA, l_reg, pa0, pa1, pa2, pa3); SBAR();
    pv_tile<0, SK>(o, vb0, pa0, pa1, pa2, pa3, ACT(even ? NT - 2 : NT - 1));
    if (even) { BIAST(pB0, pB1, NT - 1); MASKT(pB0, pB1, NT - 1); partialSM(pB0, pB1, m_reg, mnB, alB); __syncthreads(); RESC(alB);
        finishSM(pB0, pB1, alB, l_reg, pa0, pa1, pa2, pa3); SBAR(); pv_tile<1, SK>(o, vb0, pa0, pa1, pa2, pa3, ACT(NT - 1)); }
    SBAR(); SEAM_K0();
    if (hi == 0) li_l[r32] = l_reg; asm volatile("s_waitcnt lgkmcnt(0)" ::: "memory");
    float rli[16];
#pragma unroll
    for (int r = 0; r < 16; ++r) rli[r] = __builtin_amdgcn_rcpf(li_l[crow(r, hi)]);
    TOut* Ow = cur.O + (size_t)(wid * QBLK) * LDO;
    float addv[4][16];
    if constexpr (MODE == 2) { const unsigned short* Yp = (const unsigned short*)cur.Y + (size_t)(wid * QBLK) * LDO; const float* Zp = (const float*)cur.Z + (size_t)(wid * QBLK) * 96;
#pragma unroll
        for (int r = 0; r < 16; ++r) { const int orow = crow(r, hi); rli[r] *= Zp[orow * 96];
#pragma unroll
            for (int d0 = 0; d0 < 4; ++d0) addv[d0][r] = __uint_as_float((unsigned)Yp[(size_t)orow * LDO + d0 * 32 + r32] << 16); } }
#pragma unroll
    for (int r = 0; r < 16; ++r) { const int orow = crow(r, hi);
#pragma unroll
        for (int d0 = 0; d0 < 4; ++d0) { float v = o[d0][r] * rli[r]; if constexpr (MODE == 2) v += addv[d0][r];
            if constexpr (same_t<TOut, float>::v) { Ow[(size_t)orow * LDO + d0 * 32 + r32] = v; }
            else { const float vn = __shfl_xor(v, 1);
                   if ((r32 & 1) == 0) *(unsigned*)(Ow + (size_t)orow * LDO + d0 * 32 + r32) = cvtpk(v, vn); } } }
    __syncthreads();
#undef RESC
#undef KBASE
#undef ACT
#undef BIAST
#undef MASKT
#undef SEAM_K0
#undef HALF_STEP
}

__host__ __device__ inline int swa_nramp(int nqb, int W, int qoff) { const int t = W - 1 - qoff; const int n = t < 0 ? 0 : t / QB + 1; return n > nqb ? nqb : n; }
__host__ __device__ inline int swa_nx(int nqb, int nramp) { return (nramp + 1) / 2 + (nqb - nramp); }
struct SwaItem { int bh, qb0, qb1; };
__device__ __forceinline__ SwaItem swa_decode(int L, int nqb, int nx, int nramp) {
    SwaItem it; it.bh = L / nx; const int x = L - it.bh * nx; const int ns = nqb - nramp;
    if (x < ns) { it.qb0 = it.qb1 = nqb - 1 - x; } else { it.qb0 = x - ns; it.qb1 = nramp - 1 - it.qb0; }
    return it;
}
template <int MODE, bool WSKIP, class TOut, int LDQ, int LDK, int LDV, int LDO, class Mk>
__device__ __forceinline__ void attn_stream(char* lds, int skv, int W, int nheads, int G, int c, const Mk& mk) {
    const int nqb = skv / QB, nramp = swa_nramp(nqb, W, 0), nx = swa_nx(nqb, nramp), total = nx * nheads;
    int L = c; if (L >= total) return;
    SwaItem it = swa_decode(L, nqb, nx, nramp); int pass = 0;
    BlockRef<TOut> cur = mk(it.bh, it.qb0);
    Seam S;
    attn_prime<TOut, LDQ, LDK, LDV>(cur, W, lds, S);
    if (__builtin_amdgcn_readfirstlane((int)threadIdx.x >> 6) >= 4) __builtin_amdgcn_s_setprio(1);
    for (;;) {
        const bool more_pass = pass == 0 && it.qb1 != it.qb0, more_item = L + G < total, last = !more_pass && !more_item;
        SwaItem itn = it; int passn = pass + 1, Ln = L;
        if (!more_pass) { passn = 0; Ln = more_item ? L + G : L; itn = swa_decode(Ln, nqb, nx, nramp); }
        const BlockRef<TOut> nxt = last ? cur : mk(itn.bh, passn ? itn.qb1 : itn.qb0);
        attn_block<MODE, WSKIP, TOut, LDQ, LDK, LDV, LDO>(cur, nxt, skv, W, lds, S);
        if (last) break;
        cur = nxt; it = itn; pass = passn; L = Ln;
    }
    __builtin_amdgcn_s_setprio(0);
}
#undef ROWK
#undef ROWV
#undef SLOAD_H
#undef SWRITE_HK
#undef SWRITE_HV
#undef SWRITE_H
}

constexpr int NWAVES = 8;
constexpr int BATCH = 4, T = 2048, M = BATCH * T, D = 4096, FF = 11008;
constexpr int NP0 = 12544, NP1 = 7424;
constexpr int N_IN0 = 12304, N_IN1 = 7264;
constexpr int E_FQ = 0, E_FK = 2048, E_FV = 4096, E_DQ = 6144, E_DK = 8192, E_DV = 10240, E_FG = 12288;
constexpr int O_Q = 0, O_KC = 4096, O_VC = 4608, O_KS = 5120, O_VS = 5632, O_KW = 6144, O_VW = 6656, O_GT = 7168;
constexpr int NCMP = 127, WINDOW = 512;
constexpr float RMS_EPS = 1e-6f;
constexpr int CAUSAL_W = 1 << 30;

typedef unsigned short bf16;
typedef unsigned v4u __attribute__((ext_vector_type(4)));
typedef unsigned v2u __attribute__((ext_vector_type(2)));
typedef float f32x4 __attribute__((ext_vector_type(4)));
typedef float f32x2 __attribute__((ext_vector_type(2)));
#define LDS_WAIT() asm volatile("s_waitcnt lgkmcnt(0)" ::: "memory")

constexpr size_t MiB = 1u << 20;
constexpr size_t WS_CTL = 0, CTL_ZERO_BYTES = 1 * MiB;
constexpr size_t SZ_WGU = (size_t)2 * FF * D * 2, SZ_WD = (size_t)D * FF * 2, SZ_WIN0 = (size_t)NP0 * D * 2, SZ_WIN1 = (size_t)NP1 * D * 2, SZ_WOUT = (size_t)D * D * 2;
constexpr size_t WS_WGU = 1 * MiB;
constexpr size_t WS_WD = WS_WGU + 4 * SZ_WGU;
constexpr size_t WS_WIN0 = WS_WD + 4 * SZ_WD;
constexpr size_t WS_WOUT0 = WS_WIN0 + SZ_WIN0;
constexpr size_t WS_WIN1 = WS_WOUT0 + SZ_WOUT;
constexpr size_t WS_WOUT1 = WS_WIN1 + SZ_WIN1;
constexpr size_t WS_W1C = WS_WOUT1 + SZ_WOUT;
constexpr size_t WS_XN = WS_W1C + (size_t)512 * 4096 * 2;
constexpr size_t WS_MIX = WS_XN + (size_t)M * D * 2;
constexpr size_t WS_QROT = WS_MIX + (size_t)M * D * 2;
constexpr size_t WS_PROJ = WS_QROT + (size_t)M * D * 2;
constexpr size_t WS_SCR = WS_PROJ + (size_t)M * NP0 * 2;
constexpr size_t SZ_SCR = (size_t)3 * M * D * 4;
constexpr size_t WS_TAB = WS_SCR + SZ_SCR;
constexpr size_t WS_FG = WS_TAB + (size_t)T * 64 * 8;
constexpr size_t WS_CUM = WS_FG + (size_t)M * 16 * 4;
constexpr size_t WS_GATES = WS_CUM + (size_t)64 * T * 4;
constexpr size_t WS_ACMP = WS_GATES + (size_t)M * 96 * 4;
constexpr size_t WS_HIDC = WS_ACMP + (size_t)4096 * 4096 * 2;
constexpr size_t WS_KVC = WS_HIDC + (size_t)4096 * 256 * 2;
constexpr size_t WS_SELM = WS_KVC + (size_t)2 * 2048 * 128 * 2;
constexpr size_t WS_CBP = WS_SELM + (size_t)16 * T * 4;
constexpr size_t WS_CB = WS_CBP + (size_t)32 * 512 * 4;
constexpr size_t WS_DUMP = WS_CB + 4096;
constexpr size_t WS_NMAX = WS_DUMP + 16384;
constexpr size_t WS_PART = WS_NMAX + 4096;
constexpr size_t WS_H = WS_PART + (size_t)M * 64 * 4;
constexpr size_t WS_END = WS_H + (size_t)M * D * 2;
constexpr int CW_BAR = 4096;

constexpr int RING_BYTES = 131072;
constexpr int MISC_OFF = RING_BYTES + 320;
constexpr int RS_OFF = RING_BYTES + 1024;
constexpr int LDS_BYTES = 147456;

__device__ __forceinline__ unsigned f2bf(float f) { unsigned u = __builtin_bit_cast(unsigned, f); return (u + 0x7fffu + ((u >> 16) & 1u)) >> 16; }
__device__ __forceinline__ unsigned pk2(float lo, float hi) { return f2bf(lo) | (f2bf(hi) << 16); }
__device__ __forceinline__ float bf_lo(unsigned w) { return __builtin_bit_cast(float, w << 16); }
__device__ __forceinline__ float bf_hi(unsigned w) { return __builtin_bit_cast(float, w & 0xffff0000u); }
__device__ __forceinline__ float wave_sum(float v) {
#pragma unroll
    for (int o = 1; o < 64; o <<= 1) v += __shfl_xor(v, o);
    return v;
}

struct Args { const float* in[29]; float* out; unsigned char* ws; int ph_lo, ph_hi; };
struct Ctx {
    int tid, lane, wave, G, bid, gw, NGW;
    unsigned char* ws;
    float* out;
};

__device__ __forceinline__ int rowmap(int mode, int off, int n) {
    if (mode == 1) return ((n >> 7) << 8) + (n & 127) + off;
    if (mode == 2) return n < 6144 ? n : (n < 6160 ? E_FG + (n - 6144) : n - 16);
    return n + off;
}
struct Pend { f32x4 v[2][8]; float gk[2][8]; bf16* d; int K; };
__device__ __forceinline__ void tr_issue(Pend& p, const float* W, int K, int N, bf16* WT, int mode, int off, int item, int lane, bool tiled, bf16* dump, const float* gain, bool has_gain) {
    const int nblk = (N + 63) / 64, kb = item / nblk, nb = item - kb * nblk, k0 = 64 * kb, cq = lane & 15, rq = lane >> 4, n = 64 * nb + 4 * cq;
    const bool ok = n < N; const int nc = ok ? n : N - 4;
    bf16* d = tiled ? WT + ((size_t)kb * N + rowmap(mode, off, nc)) * 64 + 8 * rq : WT + (size_t)rowmap(mode, off, nc) * K + k0 + 8 * rq;
    p.d = ok ? d : dump + lane * 128; p.K = ok ? (tiled ? 64 : K) : 0;
    const float* src = W + (size_t)(k0 + 8 * rq) * N + nc;
#pragma unroll
    for (int j = 0; j < 2; ++j)
#pragma unroll
        for (int i = 0; i < 8; ++i) { p.v[j][i] = *(const f32x4*)(src + (size_t)(32 * j + i) * N); const float g = gain[has_gain ? k0 + 8 * rq + 32 * j + i : 0]; p.gk[j][i] = has_gain ? g : 1.0f; }
}
__device__ __forceinline__ void tr_flush(Pend& p) {
#pragma unroll
    for (int e = 0; e < 4; ++e) { bf16* drow = p.d + (size_t)e * p.K;
#pragma unroll
        for (int j = 0; j < 2; ++j) { v4u o; o.x = pk2(p.v[j][0][e] * p.gk[j][0], p.v[j][1][e] * p.gk[j][1]); o.y = pk2(p.v[j][2][e] * p.gk[j][2], p.v[j][3][e] * p.gk[j][3]); o.z = pk2(p.v[j][4][e] * p.gk[j][4], p.v[j][5][e] * p.gk[j][5]); o.w = pk2(p.v[j][6][e] * p.gk[j][6], p.v[j][7][e] * p.gk[j][7]);
            *(v4u*)(drow + 32 * j) = o; } }
}
__device__ __forceinline__ void rms_row_bf16(const float* xrow, const float* gain, bf16* orow, int lane) {
    const f32x4* xr = (const f32x4*)xrow + lane; const f32x4* gr = (const f32x4*)gain + lane;
    f32x4 v[16]; float s = 0.f;
#pragma unroll
    for (int j = 0; j < 16; ++j) { v[j] = xr[64 * j]; s += (v[j].x * v[j].x + v[j].y * v[j].y) + (v[j].z * v[j].z + v[j].w * v[j].w); }
    const float r = 1.0f / sqrtf(wave_sum(s) * (1.0f / D) + RMS_EPS);
    v2u* o8 = (v2u*)orow + lane;
#pragma unroll
    for (int j = 0; j < 16; ++j) { const f32x4 g = gr[64 * j]; v2u w; w.x = pk2(v[j].x * r * g.x, v[j].y * r * g.y); w.y = pk2(v[j].z * r * g.z, v[j].w * r * g.w); o8[64 * j] = w; }
}
__device__ __forceinline__ void norm_phase(const Ctx& C, const float* src, const float* gain, bf16* dst) {
    for (int m = C.gw; m < M; m += C.NGW) rms_row_bf16(src + (size_t)m * D, gain, dst + (size_t)m * D, C.lane);
}
__device__ __forceinline__ float load_hrow(const bf16* hrow, int lane, f32x4 (&v)[8][2]) {
    const v4u* hr = (const v4u*)hrow + lane; float s = 0.f;
#pragma unroll
    for (int j = 0; j < 8; ++j) { const v4u w = hr[64 * j];
        v[j][0] = (f32x4){bf_lo(w.x), bf_hi(w.x), bf_lo(w.y), bf_hi(w.y)}; v[j][1] = (f32x4){bf_lo(w.z), bf_hi(w.z), bf_lo(w.w), bf_hi(w.w)};
#pragma unroll
        for (int q = 0; q < 2; ++q) s += (v[j][q].x * v[j][q].x + v[j][q].y * v[j][q].y) + (v[j][q].z * v[j][q].z + v[j][q].w * v[j][q].w); }
    return 1.0f / sqrtf(wave_sum(s) * (1.0f / D) + RMS_EPS);
}
__device__ __forceinline__ void norm_phase_h(const Ctx& C, const bf16* h, const float* gain, bf16* dst) {
    for (int m = C.gw; m < M; m += C.NGW) { f32x4 v[8][2]; const float r = load_hrow(h + (size_t)m * D, C.lane, v);
        const f32x4* gr = (const f32x4*)gain + 2 * C.lane; v4u* o = (v4u*)(dst + (size_t)m * D) + C.lane;
#pragma unroll
        for (int j = 0; j < 8; ++j) { const f32x4 g0 = gr[128 * j], g1 = gr[128 * j + 1]; v4u w;
            w.x = pk2(v[j][0].x * r * g0.x, v[j][0].y * r * g0.y); w.y = pk2(v[j][0].z * r * g0.z, v[j][0].w * r * g0.w);
            w.z = pk2(v[j][1].x * r * g1.x, v[j][1].y * r * g1.y); w.w = pk2(v[j][1].z * r * g1.z, v[j][1].w * r * g1.w); o[64 * j] = w; } }
}
__device__ __forceinline__ void final_norm_phase(const Ctx& C, const bf16* h, const float* gain, float* out) {
    for (int m = C.gw; m < M; m += C.NGW) { f32x4 v[8][2]; const float r = load_hrow(h + (size_t)m * D, C.lane, v);
        const f32x4* gr = (const f32x4*)gain + 2 * C.lane; f32x4* o = (f32x4*)(out + (size_t)m * D) + 2 * C.lane;
#pragma unroll
        for (int j = 0; j < 8; ++j) { const f32x4 g0 = gr[128 * j], g1 = gr[128 * j + 1];
            o[128 * j] = (f32x4){v[j][0].x * r * g0.x, v[j][0].y * r * g0.y, v[j][0].z * r * g0.z, v[j][0].w * r * g0.w};
            o[128 * j + 1] = (f32x4){v[j][1].x * r * g1.x, v[j][1].y * r * g1.y, v[j][1].z * r * g1.z, v[j][1].w * r * g1.w}; } }
}

__device__ __forceinline__ void prep_rstd(const float* part, int pm, LAS float* rs, int tid) {
    const int row = tid >> 1, half = tid & 1;
    const f32x4* p = (const f32x4*)(part + ((size_t)pm * 256 + row) * 64 + half * 32);
    f32x4 a = p[0];
#pragma unroll
    for (int i = 1; i < 8; ++i) a += p[i];
    float s = (a[0] + a[1]) + (a[2] + a[3]); s += __shfl_xor(s, 1);
    if (half == 0) rs[row] = 1.0f / sqrtf(s * (1.0f / D) + RMS_EPS);
    __syncthreads();
}
constexpr int CI_F = 11008, CI_F3 = 3 * CI_F, CI_W0 = 64 * 193, CI_WO = 64 * 64, CI_W1 = 64 * 114, CI_C = 64 * 4;
constexpr int CB_F0 = 0, CB_W0 = CB_F0 + CI_F3, CB_WO0 = CB_W0 + CI_W0, CB_F1 = CB_WO0 + CI_WO, CB_F2 = CB_F1 + CI_F3, CB_W1 = CB_F2 + CI_F3, CB_C = CB_W1 + CI_W1,
              CB_WO1 = CB_C + 2 * CI_C, CB_F3 = CB_WO1 + CI_WO, CB_END = CB_F3 + CI_F3;
__device__ __forceinline__ void conv_issue(Pend& p, const Args& A, unsigned char* ws, int g, int lane) {
    const float* src; bf16* dst; int K = D, N = D, mode = 0, off = 0, r = g, f = -1; bool tiled = false; const float* gain = A.in[1]; bool has_gain = false;
    if (g < CB_W0) { f = 0; }
    else if (g < CB_WO0) { r = g - CB_W0; src = A.in[10]; dst = (bf16*)(ws + WS_WIN0); N = N_IN0; mode = 2; gain = A.in[5]; has_gain = true; }
    else if (g < CB_F1) { r = g - CB_WO0; src = A.in[17]; dst = (bf16*)(ws + WS_WOUT0); }
    else if (g < CB_F2) { f = 1; r = g - CB_F1; }
    else if (g < CB_W1) { f = 2; r = g - CB_F2; }
    else if (g < CB_C) { r = g - CB_W1; src = A.in[18]; dst = (bf16*)(ws + WS_WIN1); N = N_IN1; gain = A.in[5] + D; has_gain = true; }
    else if (g < CB_WO1) { r = g - CB_C; N = 256; dst = (bf16*)(ws + WS_W1C); if (r < CI_C) { src = A.in[20]; } else { r -= CI_C; src = A.in[24]; off = 256; } }
    else if (g < CB_F3) { r = g - CB_WO1; src = A.in[27]; dst = (bf16*)(ws + WS_WOUT1); }
    else { f = 3; r = g - CB_F3; }
    if (f >= 0) { const int which = r / CI_F, layer = f >> 1, half = f & 1; r -= which * CI_F;
        if (which < 2) { src = (half ? (which ? A.in[8] : A.in[7]) : (which ? A.in[3] : A.in[2])) + (size_t)layer * D * FF; dst = (bf16*)(ws + WS_WGU + (size_t)f * SZ_WGU); N = FF; mode = 1; off = which * 128; gain = (half ? A.in[6] : A.in[1]) + (size_t)layer * D; has_gain = true; }
        else { src = (half ? A.in[9] : A.in[4]) + (size_t)layer * FF * D; dst = (bf16*)(ws + WS_WD + (size_t)f * SZ_WD); K = FF; tiled = true; } }
    tr_issue(p, src, K, N, dst, mode, off, r, lane, tiled, (bf16*)(ws + WS_DUMP), gain, has_gain);
}
__device__ __forceinline__ void convert_range(const Args& A, unsigned char* ws, int lo, int hi, int wi, int nw, int lane) {
    const int g0 = lo + wi;
    if (g0 >= hi) return;
    Pend P0, P1;
    conv_issue(P0, A, ws, g0, lane);
    for (int g = g0; g < hi; g += 2 * nw) {
        const int g1 = g + nw < hi ? g + nw : hi - 1, g2 = g + 2 * nw < hi ? g + 2 * nw : hi - 1;
        conv_issue(P1, A, ws, g1, lane);
        tr_flush(P0);
        conv_issue(P0, A, ws, g2, lane);
        tr_flush(P1);
    }
}
#ifndef TCAP_GU
#define TCAP_GU 6500
#endif
#ifndef TCAP_W0
#define TCAP_W0 19000
#endif
#ifndef TCAP_W1
#define TCAP_W1 9500
#endif
#ifndef TCAP_CMP
#define TCAP_CMP 18000
#endif
constexpr int T1_LO = CB_W0, T1_HI = T1_LO + TCAP_GU;
constexpr int T4_LO = CB_F1, T4_HI = T4_LO + TCAP_W0;
constexpr int T10_LO = CB_F2, T10_HI = T10_LO + TCAP_GU;
constexpr int T13_LO = CB_W1, T13_HI = T13_LO + TCAP_GU;
constexpr int T16_LO = CB_F3, T16_HI = T16_LO + TCAP_W1;
constexpr int T25_LO = CB_END - TCAP_GU, T25_HI = CB_END;
static_assert(T1_HI <= CB_WO0 && T4_HI <= CB_F2 && T10_HI <= CB_W1 && T13_HI <= CB_C && T16_HI <= T25_LO && T25_LO >= CB_F3 + 2 * CI_F, "tail ranges");
__device__ __forceinline__ void prologue_phase(const Args& A, const Ctx& C, LAS unsigned char* lds) {
    convert_range(A, C.ws, CB_F0, T1_LO, C.gw, C.NGW, C.lane);
    convert_range(A, C.ws, T1_HI, T4_LO, C.gw, C.NGW, C.lane);
    convert_range(A, C.ws, T4_HI, T10_LO, C.gw, C.NGW, C.lane);
    convert_range(A, C.ws, T10_HI, T13_LO, C.gw, C.NGW, C.lane);
    convert_range(A, C.ws, T13_HI, T16_LO, C.gw, C.NGW, C.lane);
    convert_range(A, C.ws, T16_HI, T25_LO, C.gw, C.NGW, C.lane);
    { const int gt = C.bid * 512 + C.tid, NGT = C.G * 512; const v4u z = {0u, 0u, 0u, 0u};
        v4u* p0 = (v4u*)(C.ws + WS_WIN0 + (size_t)N_IN0 * D * 2); const int n0 = (NP0 - N_IN0) * D * 2 / 16;
        for (int i = gt; i < n0; i += NGT) p0[i] = z;
        v4u* p1 = (v4u*)(C.ws + WS_WIN1 + (size_t)N_IN1 * D * 2); const int n1 = (NP1 - N_IN1) * D * 2 / 16;
        for (int i = gt; i < n1; i += NGT) p1[i] = z;
        f32x2* tab = (f32x2*)(C.ws + WS_TAB);
        for (int i = gt; i < T * 64; i += NGT) { const int t = i >> 6, k = i & 63;
            const float inv = powf(10000.0f, -(float)k / 64.0f); const float ang = (float)t * inv;
            tab[i] = (f32x2){(float)cos((double)ang), (float)sin((double)ang)}; }
    }
    { float* cbp = (float*)(C.ws + WS_CBP);
        if (C.wave == 0) for (int u = C.bid; u < 256; u += C.G) { const int mat = u >> 7, jb = (u >> 5) & 3, kc = u & 31;
            const float* pe = mat ? A.in[23] : A.in[19]; const float* w1 = mat ? A.in[24] : A.in[20]; const int j = jb * 64 + C.lane;
            float s = 0.f;
            for (int k = kc * 128; k < kc * 128 + 128; ++k) s += pe[k] * w1[(size_t)k * 256 + j];
            cbp[kc * 512 + mat * 256 + j] = s; } }
    { float* part = (float*)(C.ws + WS_PART); bf16* XNp = (bf16*)(C.ws + WS_XN);
        for (int m = C.gw; m < M; m += C.NGW) { const f32x4* xr = (const f32x4*)(A.in[0] + (size_t)m * D) + C.lane; v2u* o8 = (v2u*)(XNp + (size_t)m * D) + C.lane; float ss = 0.f;
#pragma unroll
            for (int j = 0; j < 16; ++j) { const f32x4 v = xr[64 * j]; v2u w; w.x = pk2(v.x, v.y); w.y = pk2(v.z, v.w); o8[64 * j] = w;
                ss += (bf_lo(w.x) * bf_lo(w.x) + bf_hi(w.x) * bf_hi(w.x)) + (bf_lo(w.y) * bf_lo(w.y) + bf_hi(w.y) * bf_hi(w.y)); }
            ss = wave_sum(ss); part[(size_t)m * 64 + C.lane] = C.lane == 0 ? ss : 0.f; } }
}

__device__ __forceinline__ void rope_heads(const bf16* src, bf16* dst, int nh, const f32x2* tabrow, int lane) {
    const int i0 = 8 * (lane & 7); const f32x4* tp = (const f32x4*)(tabrow + i0);
    const f32x4 t0 = tp[0], t1 = tp[1], t2 = tp[2], t3 = tp[3];
    for (int h = (lane >> 3); h < nh; h += 8) {
        const v4u a = *(const v4u*)(src + h * 128 + i0), b = *(const v4u*)(src + h * 128 + 64 + i0);
        v4u o1, o2;
#define ROPE2(AW, BW, T, O1, O2) do { const float x1l = bf_lo(AW), x1h = bf_hi(AW), x2l = bf_lo(BW), x2h = bf_hi(BW); \
            O1 = pk2(x1l * T.x - x2l * T.y, x1h * T.z - x2h * T.w); O2 = pk2(x2l * T.x + x1l * T.y, x2h * T.z + x1h * T.w); } while (0)
        ROPE2(a.x, b.x, t0, o1.x, o2.x); ROPE2(a.y, b.y, t1, o1.y, o2.y); ROPE2(a.z, b.z, t2, o1.z, o2.z); ROPE2(a.w, b.w, t3, o1.w, o2.w);
#undef ROPE2
        *(v4u*)(dst + h * 128 + i0) = o1; *(v4u*)(dst + h * 128 + 64 + i0) = o2;
    }
}
__device__ __forceinline__ void even_post_phase(const Args& A, const Ctx& C) {
    bf16* proj = (bf16*)(C.ws + WS_PROJ); const f32x2* tab = (const f32x2*)(C.ws + WS_TAB);
    for (int tok = C.gw; tok < M; tok += C.NGW) { bf16* p = proj + (size_t)tok * NP0 + E_DQ; rope_heads(p, p, 32, tab + (tok & (T - 1)) * 64, C.lane); }
    const float* fg = (const float*)(C.ws + WS_FG); float* cum = (float*)(C.ws + WS_CUM); const float* bfg = A.in[11];
    { float* nmax = (float*)(C.ws + WS_NMAX); const int sub = C.lane & 15, rr = C.lane >> 4;
        for (int task = C.gw; task < 1024; task += C.NGW) { const int which = task & 1, blk = (task >> 1) & 7, bh = task >> 4, b = bh >> 4, h = bh & 15;
            const bf16* p = proj + (size_t)(b * T + blk * 256 + rr) * NP0 + (which ? E_FK : E_FQ) + h * 128 + 8 * sub; float mx = 0.f;
#pragma unroll 8
            for (int it = 0; it < 64; ++it) { const v4u w = *(const v4u*)(p + (size_t)(4 * it) * NP0);
                float ss = (bf_lo(w.x) * bf_lo(w.x) + bf_hi(w.x) * bf_hi(w.x)) + (bf_lo(w.y) * bf_lo(w.y) + bf_hi(w.y) * bf_hi(w.y)) + (bf_lo(w.z) * bf_lo(w.z) + bf_hi(w.z) * bf_hi(w.z)) + (bf_lo(w.w) * bf_lo(w.w) + bf_hi(w.w) * bf_hi(w.w));
                ss += __shfl_xor(ss, 1); ss += __shfl_xor(ss, 2); ss += __shfl_xor(ss, 4); ss += __shfl_xor(ss, 8);
                mx = fmaxf(mx, ss); }
            mx = fmaxf(mx, __shfl_xor(mx, 16)); mx = fmaxf(mx, __shfl_xor(mx, 32));
            if (C.lane == 0) nmax[which * 512 + bh * 8 + blk] = mx; } }
    for (int task = C.gw; task < 64 * (T / 64); task += C.NGW) { const int s = task >> 5, c = task & 31, b = s >> 4, h = s & 15; const float bias = bfg[h];
        double acc = 0.0;
        for (int cc = 0; cc < c; ++cc) { const float x = fg[(size_t)(b * T + cc * 64 + C.lane) * 16 + h] + bias; acc += (double)(fminf(x, 0.f) - log1pf(expf(-fabsf(x)))); }
#pragma unroll
        for (int o = 1; o < 64; o <<= 1) acc += __shfl_xor(acc, o);
        const int t = c * 64 + C.lane;
        const float x = fg[(size_t)(b * T + t) * 16 + h] + bias;
        double v = (double)(fminf(x, 0.f) - log1pf(expf(-fabsf(x))));
#pragma unroll
        for (int o = 1; o < 64; o <<= 1) { const double u = __shfl_up(v, o); if (C.lane >= o) v += u; }
        cum[(size_t)s * T + t] = (float)(v + acc); }
}
__device__ __forceinline__ void even_combine_phase(const Args& A, const Ctx& C) {
    const bf16* O1 = (const bf16*)(C.ws + WS_SCR); const bf16* O2 = O1 + (size_t)M * 2048; bf16* mix = (bf16*)(C.ws + WS_MIX);
    float s1 = A.in[12][C.lane] * A.in[13][C.lane] + A.in[12][C.lane + 64] * A.in[13][C.lane + 64];
    float s2 = A.in[14][C.lane] * A.in[15][C.lane] + A.in[14][C.lane + 64] * A.in[15][C.lane + 64];
    const float lam_init = 0.2f;
    const float lam = expf(wave_sum(s1)) - expf(wave_sum(s2)) + lam_init;
    const f32x4 sg = ((const f32x4*)A.in[16])[C.lane];
    for (int tok = C.gw; tok < M; tok += C.NGW) {
        const v2u* a1 = (const v2u*)(O1 + (size_t)tok * 2048) + C.lane; const v2u* a2 = (const v2u*)(O2 + (size_t)tok * 2048) + C.lane;
        v2u* o = (v2u*)(mix + (size_t)tok * D + 2048) + C.lane;
#pragma unroll
        for (int h = 0; h < 8; ++h) { const v2u p1 = a1[64 * h], p2 = a2[64 * h];
            const f32x4 x = (f32x4){bf_lo(p1.x), bf_hi(p1.x), bf_lo(p1.y), bf_hi(p1.y)} - (f32x4){bf_lo(p2.x), bf_hi(p2.x), bf_lo(p2.y), bf_hi(p2.y)} * lam;
            const float ss = wave_sum((x.x * x.x + x.y * x.y) + (x.z * x.z + x.w * x.w));
            const float r = 1.0f / sqrtf(ss * (1.0f / 256.0f) + RMS_EPS);
            v2u w; w.x = pk2(x.x * r * sg.x * (1.0f - lam_init), x.y * r * sg.y * (1.0f - lam_init)); w.y = pk2(x.z * r * sg.z * (1.0f - lam_init), x.w * r * sg.w * (1.0f - lam_init));
            o[64 * h] = w; }
    }
}
__device__ __forceinline__ void odd_post_phase(const Args& A, const Ctx& C) {
    bf16* proj = (bf16*)(C.ws + WS_PROJ); bf16* qrot = (bf16*)(C.ws + WS_QROT); const f32x2* tab = (const f32x2*)(C.ws + WS_TAB);
    for (int tok = C.gw; tok < M; tok += C.NGW) { bf16* p = proj + (size_t)tok * NP1; const f32x2* tr = tab + (tok & (T - 1)) * 64;
        rope_heads(p + O_Q, qrot + (size_t)tok * D, 32, tr, C.lane);
        rope_heads(p + O_KS, p + O_KS, 4, tr, C.lane);
        rope_heads(p + O_KW, p + O_KW, 4, tr, C.lane); }
    bf16* AC = (bf16*)(C.ws + WS_ACMP);
    for (int u = C.gw; u < 4096; u += C.NGW) { const int mat = u >> 11, r = u & 2047; v4u* dst = (v4u*)(AC + (size_t)u * 4096) + C.lane;
        if (r < 2032) { const int g = r & 3, bn = r >> 2, b = bn / NCMP, n = bn - b * NCMP;
            const bf16* src = proj + (size_t)(b * T + 16 * n + (C.lane >> 4)) * NP1 + (mat ? O_VC : O_KC) + g * 128 + 8 * (C.lane & 15);
#pragma unroll
            for (int l = 0; l < 8; ++l) dst[l * 64] = *(const v4u*)(src + (size_t)(4 * l) * NP1); }
        else { const v4u z = {0u, 0u, 0u, 0u};
#pragma unroll
            for (int l = 0; l < 8; ++l) dst[l * 64] = z; } }
    if (C.bid == 0) { const float* cbp = (const float*)(C.ws + WS_CBP); float* cb = (float*)(C.ws + WS_CB); const int j = C.tid;
        float s = (j < 256 ? A.in[21] : A.in[25])[j & 255];
        for (int kc = 0; kc < 32; ++kc) s += cbp[kc * 512 + j];
        cb[j] = s; }
}
__device__ __forceinline__ void cmp2_phase(const Args& A, const Ctx& C) {
    const bf16* hid = (const bf16*)(C.ws + WS_HIDC); bf16* kvc = (bf16*)(C.ws + WS_KVC);
    const int gt = C.bid * 512 + C.tid, NGT = C.G * 512;
    for (int o = gt; o < 2 * 2048 * 128; o += NGT) { const int d = o & 127, r = (o >> 7) & 2047, mat = o >> 18;
        float s = 0.f;
        if (r < 2032) { const float* w2 = (mat ? A.in[26] : A.in[22]) + d; const unsigned* hr = (const unsigned*)(hid + (size_t)(mat * 2048 + r) * 256);
#pragma unroll 8
            for (int j = 0; j < 128; ++j) { const unsigned w = hr[j]; s += bf_lo(w) * w2[(size_t)(2 * j) * 128]; s += bf_hi(w) * w2[(size_t)(2 * j + 1) * 128]; } }
        kvc[o] = (bf16)f2bf(s); }
}
__device__ __forceinline__ void odd_combine_phase(const Ctx& C) {
    const bf16* oc = (const bf16*)(C.ws + WS_SCR); const bf16* os = oc + (size_t)M * D; const bf16* ow = os + (size_t)M * D;
    const float* gates = (const float*)(C.ws + WS_GATES); bf16* mix = (bf16*)(C.ws + WS_MIX);
    for (int tok = C.gw; tok < M; tok += C.NGW) { const size_t ro = (size_t)tok * D;
#pragma unroll 4
        for (int j = 0; j < 16; ++j) { const int col = 4 * (C.lane + 64 * j), head = col >> 7; const float* gp = gates + (size_t)tok * 96 + head * 3;
            const float g0 = gp[0], g1 = gp[1], g2 = gp[2];
            const v2u pa = *(const v2u*)(oc + ro + col), pb = *(const v2u*)(os + ro + col), pc = *(const v2u*)(ow + ro + col);
            const f32x4 a = {bf_lo(pa.x), bf_hi(pa.x), bf_lo(pa.y), bf_hi(pa.y)}, b = {bf_lo(pb.x), bf_hi(pb.x), bf_lo(pb.y), bf_hi(pb.y)}, c = {bf_lo(pc.x), bf_hi(pc.x), bf_lo(pc.y), bf_hi(pc.y)};
            const f32x4 r = a * g0 + b * g1 + c * g2; v2u w; w.x = pk2(r.x, r.y); w.y = pk2(r.z, r.w); *(v2u*)(mix + ro + col) = w; } }
}

__device__ __forceinline__ void cmp_attn_phase(const Ctx& C, char* lds) {
    using namespace att;
    const int tid = C.tid, wid = C.wave, lane = C.lane, r32 = lane & 31, hi = lane >> 5;
    char* V_lds = lds; char* K_lds = lds + 2 * SHM_V;
    float* impw = (float*)(lds + 65536);
    float* imps = impw + 8 * 32 * 33;
    const att::bf16* proj = (const att::bf16*)(C.ws + WS_PROJ);
    const att::bf16* kc = (const att::bf16*)(C.ws + WS_KVC); const att::bf16* vc = kc + 2048 * 128;
    att::bf16* ocmp = (att::bf16*)(C.ws + WS_SCR); unsigned* selm = (unsigned*)(C.ws + WS_SELM);
    const unsigned short* owin = (const unsigned short*)(C.ws + WS_SCR) + (size_t)2 * M * D; const float* gates = (const float*)(C.ws + WS_GATES);
    const int vb0 = (int)(uintptr_t)V_lds + v_rd_base(lane);
    for (int u = C.bid; u < 256; u += C.G) {
        const int bg = u >> 4, b = bg >> 2, g = bg & 3, tt0 = (u & 15) * 4;
        __syncthreads();
        { const int sc = (tid & 15) * 8;
#pragma unroll
            for (int i = 0; i < 4; ++i) { const int row = (tid >> 4) + 32 * i;
                bf16x8 kv = {0, 0, 0, 0, 0, 0, 0, 0}, vv = {0, 0, 0, 0, 0, 0, 0, 0};
                if (row < NCMP) { const size_t ro = ((size_t)(b * NCMP + row) * 4 + g) * 128 + sc; kv = load8(kc + ro); vv = load8(vc + ro); }
                const int tile = row >> 6, r6 = row & 63;
                *(bf16x8*)(K_lds + tile * SHM_K + KSWZ(r6, sc * 2)) = kv;
                *(bf16x8*)(V_lds + tile * SHM_V + v_st(r6, sc)) = vv; } }
        __syncthreads();
        bf16x8 qr[8];
        { const att::bf16* qp = proj + (size_t)(b * T + tt0 * 32 + r32) * NP1 + O_Q + (g * 8 + wid) * 128 + hi * 8;
#pragma unroll
            for (int d0 = 0; d0 < 8; ++d0) qr[d0] = load8(qp + d0 * 16); }
        for (int ti = 0; ti < 4; ++ti) {
            const int t0 = (tt0 + ti) * 32, t = t0 + r32, hq = g * 8 + wid;
            f32x16 s[4];
            qkt<0, false>(s[0], s[1], K_lds, r32, hi, qr, true);
            qkt<1, false>(s[2], s[3], K_lds, r32, hi, qr, true);
            int nvalid = (t - 15) >> 4; nvalid = nvalid < 0 ? 0 : nvalid;
            const float NEG = -__builtin_inff(); float pmax = NEG;
#pragma unroll
            for (int q = 0; q < 4; ++q)
#pragma unroll
                for (int r = 0; r < 16; ++r) { const int c = (r & 3) + 8 * (r >> 2) + 4 * hi + 32 * q; if (c >= nvalid) s[q][r] = NEG; pmax = fmaxf(pmax, s[q][r]); }
            { auto rr = __builtin_amdgcn_permlane32_swap(__float_as_uint(pmax), __float_as_uint(pmax), false, false);
              pmax = fmaxf(__uint_as_float(rr[0]), __uint_as_float(rr[1])); }
            constexpr float C2 = 1.4426950408889634f * SCALE;
            const float mL = nvalid > 0 ? -pmax * C2 : 0.f;
            float ps = 0.f;
#pragma unroll
            for (int q = 0; q < 4; ++q)
#pragma unroll
                for (int r = 0; r < 16; ++r) { s[q][r] = __builtin_amdgcn_exp2f(fmaf(s[q][r], C2, mL)); ps += s[q][r]; }
            { auto rr = __builtin_amdgcn_permlane32_swap(__float_as_uint(ps), __float_as_uint(ps), false, false);
              ps = __uint_as_float(rr[0]) + __uint_as_float(rr[1]); }
            const float inv = nvalid > 0 ? 1.0f / ps : 0.f;
#pragma unroll
            for (int q = 0; q < 4; ++q)
#pragma unroll
                for (int r = 0; r < 16; ++r) s[q][r] *= inv;
            { float Gi[16], Lp[16];
#pragma unroll
                for (int i = 0; i < 16; ++i) { const int q = i >> 2, e = 4 * (i & 3);
                    Gi[i] = (s[q][e] + s[q][e + 1]) + (s[q][e + 2] + s[q][e + 3]); Lp[i] = __shfl_xor(s[q][e + 3], 32); }
                float* iw = impw + (wid * 32 + r32) * 33;
#pragma unroll
                for (int i = 0; i < 16; ++i) { const float prev = hi ? Lp[i] : (i > 0 ? Lp[i > 0 ? i - 1 : 0] : 0.f); iw[2 * i + hi] = Gi[i] + prev; } }
            bf16x8 pa0, pa1, pa2, pa3, pb0, pb1, pb2, pb3;
            PK4(s[0], 0, pa0); PK4(s[0], 8, pa1); PK4(s[1], 0, pa2); PK4(s[1], 8, pa3);
            PK4(s[2], 0, pb0); PK4(s[2], 8, pb1); PK4(s[3], 0, pb2); PK4(s[3], 8, pb3);
            f32x16 o[4] = {};
            pv_tile<0, false>(o, vb0, pa0, pa1, pa2, pa3, true);
            pv_tile<1, false>(o, vb0, pb0, pb1, pb2, pb3, true);
            { const int tn = (ti < 3 ? t0 + 32 : t0) + r32; const att::bf16* qp = proj + (size_t)(b * T + tn) * NP1 + O_Q + hq * 128 + hi * 8;
#pragma unroll
                for (int d0 = 0; d0 < 8; ++d0) qr[d0] = load8(qp + d0 * 16); }
            att::bf16* Ow = ocmp + (size_t)(b * T + t0) * D + hq * 128;
            { const unsigned short* Wp = owin + (size_t)(b * T + t0) * D + hq * 128; const float* Gp = gates + (size_t)(b * T + t0) * 96 + hq * 3;
#pragma unroll
                for (int q = 0; q < 4; ++q) { const unsigned rb = (unsigned)(8 * q + 4 * hi);
                    float gc[4], gw[4], wv[4][4];
#pragma unroll
                    for (int e = 0; e < 4; ++e) { gc[e] = Gp[(rb + e) * 96]; gw[e] = Gp[(rb + e) * 96 + 2];
#pragma unroll
                        for (int d0 = 0; d0 < 4; ++d0) wv[d0][e] = __uint_as_float((unsigned)Wp[(rb + e) * D + d0 * 32 + r32] << 16); }
#pragma unroll
                    for (int e = 0; e < 4; ++e)
#pragma unroll
                        for (int d0 = 0; d0 < 4; ++d0) { const float v = o[d0][4 * q + e] * gc[e] + wv[d0][e] * gw[e], vn = __shfl_xor(v, 1);
                            if ((r32 & 1) == 0) *(unsigned*)(Ow + (rb + e) * D + d0 * 32 + r32) = cvtpk(v, vn); }
                    asm volatile("" ::: "memory"); } }
            __syncthreads();
#pragma unroll
            for (int k = 0; k < 2; ++k) { const int idx = tid + 512 * k, tok = idx >> 5, j = idx & 31; float a = 0.f;
#pragma unroll
                for (int w = 0; w < 8; ++w) a += impw[(w * 32 + tok) * 33 + j];
                imps[tok * 33 + j] = a; }
            __syncthreads();
#pragma unroll
            for (int k = 0; k < 2; ++k) { const int idx = tid + 512 * k, tok = idx >> 5, j = idx & 31, tq = t0 + tok, blk = tq >> 6;
                bool sel;
                if (blk <= 15) sel = j <= blk;
                else { const bool forced = (j == 0) || (j == blk) || (j == blk - 1), cand = (j >= 1) && (j <= blk - 2);
                    const float v = imps[tok * 33 + j]; int rank = 0;
                    for (int jj = 1; jj <= blk - 2; ++jj) { const float x = imps[tok * 33 + jj]; rank += (x > v || (x == v && jj < j)) ? 1 : 0; }
                    sel = forced || (cand && rank < 13); }
                const unsigned long long bal = __ballot(sel); const unsigned m32 = (lane < 32) ? (unsigned)bal : (unsigned)(bal >> 32);
                if (j == 0) selm[(size_t)bg * T + tq] = m32; }
        }
    }
}

struct MkFox { const bf16* proj; bf16* mix; const float* cum; const float* nmax;
    __device__ __forceinline__ att::BlockRef<att::bf16> operator()(int bh, int qb) const { const int b = bh >> 4, h = bh & 15; att::BlockRef<att::bf16> r;
        r.Q = (const att::bf16*)(proj + (size_t)(b * T + qb * 256) * NP0 + E_FQ + h * 128); r.K = (const att::bf16*)(proj + (size_t)(b * T) * NP0 + E_FK + h * 128);
        r.V = (const att::bf16*)(proj + (size_t)(b * T) * NP0 + E_FV + h * 128); r.O = (att::bf16*)(mix + (size_t)(b * T + qb * 256) * D + h * 128);
        r.X = cum + (size_t)bh * T; r.Y = nullptr; r.Z = nullptr; r.P0 = qb * 256;
        { const int lane = threadIdx.x & 63; float km2 = 0.f;
#pragma unroll
            for (int j = 0; j < 8; ++j) { const float v = nmax[512 + bh * 8 + j]; km2 = (j <= qb && v > km2) ? v : km2; }
            const float bound = 2.0f * 0.08838834764831845f * sqrtf(nmax[bh * 8 + qb]) * sqrtf(km2) * 1.001f;
            const float c0 = cum[(size_t)bh * T + qb * 256], cj = cum[(size_t)bh * T + 64 * (lane & 31) + 63];
            const unsigned skip = (unsigned)__ballot(c0 - cj + bound < -110.0f);
            r.J0 = __builtin_ctz(~skip | 0x80000000u); }
        return r; } };
struct MkDiff { const bf16* proj; att::bf16* O1; att::bf16* O2;
    __device__ __forceinline__ att::BlockRef<att::bf16> operator()(int bh, int qb) const { const int b = bh >> 5, rem = bh & 31, h = rem >> 2, c = (rem >> 1) & 1, e = rem & 1; att::BlockRef<att::bf16> r;
        r.Q = (const att::bf16*)(proj + (size_t)(b * T + qb * 256) * NP0 + E_DQ + h * 256 + c * 128); r.K = (const att::bf16*)(proj + (size_t)(b * T) * NP0 + E_DK + h * 256 + c * 128);
        r.V = (const att::bf16*)(proj + (size_t)(b * T) * NP0 + E_DV + h * 256 + e * 128); r.O = (c ? O2 : O1) + (size_t)(b * T + qb * 256) * 2048 + h * 256 + e * 128;
        r.X = nullptr; r.Y = nullptr; r.Z = nullptr; r.P0 = qb * 256; r.J0 = 0; return r; } };
struct MkNsa { const bf16* qrot; const bf16* proj; att::bf16* O; const unsigned* selm; int kcol, vcol; const bf16* addend; const float* gates;
    __device__ __forceinline__ att::BlockRef<att::bf16> operator()(int bh, int qb) const { const int b = bh >> 5, h = bh & 31, g = h >> 3; att::BlockRef<att::bf16> r;
        r.Q = (const att::bf16*)(qrot + (size_t)(b * T + qb * 256) * D + h * 128); r.K = (const att::bf16*)(proj + (size_t)(b * T) * NP1 + kcol + g * 128);
        r.V = (const att::bf16*)(proj + (size_t)(b * T) * NP1 + vcol + g * 128); r.O = O + (size_t)(b * T + qb * 256) * D + h * 128;
        r.X = selm + (size_t)(b * 4 + g) * T; r.Y = addend + (size_t)(b * T + qb * 256) * D + h * 128; r.Z = gates + (size_t)(b * T + qb * 256) * 96 + h * 3 + 1; r.P0 = qb * 256; r.J0 = 0; return r; } };

constexpr int NPH = 28;
static_assert(sizeof(Args) == 31 * 8 + 8, "Args has no padding");

__global__ void __launch_bounds__(NWAVES * 64, 2) hybrid_fwd(Args args) {
    extern __shared__ __attribute__((aligned(16))) unsigned char lds[];
    LAS unsigned char* ldsl = (LAS unsigned char*)lds;
    Ctx C0; Ctx& C = C0;
    C.tid = threadIdx.x; C.lane = C.tid & 63; C.wave = __builtin_amdgcn_readfirstlane(C.tid >> 6); C.G = gridDim.x; C.bid = blockIdx.x;
    C.gw = C.bid * NWAVES + C.wave; C.NGW = C.G * NWAVES; C.ws = args.ws; C.out = args.out;
    for (int u = C.tid; u < (LDS_BYTES - RING_BYTES) / 4; u += NWAVES * 64) ((LAS unsigned*)(ldsl + RING_BYTES))[u] = 0u;
    __syncthreads();
    XcdBarrier bar = xcd_barrier_post((unsigned*)(C.ws + WS_CTL) + CW_BAR, (volatile LAS unsigned*)(ldsl + MISC_OFF) + 8);
    const int lo = args.ph_lo, hi = args.ph_hi;
#ifdef ONLY_PH
#define IN(k) ((k) == ONLY_PH && lo <= (k) && (k) < hi)
#else
#define IN(k) (lo <= (k) && (k) < hi)
#endif
#define SEAM(k) do { if (IN(k) && IN((k) + 1)) xcd_barrier(bar); } while (0)
    unsigned char* ws = C.ws;
    bf16* XN = (bf16*)(ws + WS_XN); bf16* MIX = (bf16*)(ws + WS_MIX); bf16* PROJ = (bf16*)(ws + WS_PROJ); bf16* HID = (bf16*)(ws + WS_SCR);
    bf16* H = (bf16*)(ws + WS_H); float* PART = (float*)(ws + WS_PART); LAS float* RS = (LAS float*)(ldsl + RS_OFF);

#define PREP_RS() int pm0 = -1; { pg8::Unit u0; if (S.next(0, u0)) { pm0 = u0.pm; prep_rstd(PART, pm0, RS, C.tid); } } \
        const pg8::RowScale RSC{(const PG8_LAS float*)RS, pm0, PART, 1.0f / D, RMS_EPS}
#define XCD_DEAL(c_, G_) (((G_) % 8 == 0) ? ((c_) % 8) * ((G_) / 8) + (c_) / 8 : (c_))
#define GEMM_GU(f, ap) do { pg8::Gemm g{(ap), (const bf16*)(ws + WS_WGU + (size_t)(f) * SZ_WGU), M, 2 * FF, D, D, 0, 0}; pg8::StaticOrder S; S.init(M, 2 * FF, C.G, C.bid); PREP_RS(); \
        pg8::EpiSwiGLU E{HID, M, RSC}; pg8::gemm_phase<pg8::EpiSwiGLU, pg8::StaticOrder, true, true>(ldsl, g, S, E); } while (0)
#define GEMM_DOWN(f, basep) do { pg8::Gemm g{HID, (const bf16*)(ws + WS_WD + (size_t)(f) * SZ_WD), M, D, FF, FF, 1, 1}; pg8::StaticOrder S; S.init(M, D, C.G, C.bid); \
        pg8::EpiResid<false> E{(basep), H, D, 0.5f, PART}; pg8::gemm_phase<pg8::EpiResid<false>, pg8::StaticOrder, true, true>(ldsl, g, S, E); } while (0)
#define GEMM_DOWN_X(f, xp) do { pg8::Gemm g{HID, (const bf16*)(ws + WS_WD + (size_t)(f) * SZ_WD), M, D, FF, FF, 1, 1}; pg8::StaticOrder S; S.init(M, D, C.G, C.bid); \
        pg8::EpiResid<true> E{(xp), H, D, 0.5f, PART}; pg8::gemm_phase<pg8::EpiResid<true>, pg8::StaticOrder, true, true>(ldsl, g, S, E); } while (0)
#define GEMM_OUT(wsoff) do { pg8::Gemm g{MIX, (const bf16*)(ws + (wsoff)), M, D, D, D, 0, 0}; pg8::StaticOrder S; S.init(M, D, C.G, C.bid); \
        pg8::EpiResid<false> E{H, H, D, 1.0f, PART}; pg8::gemm_phase<pg8::EpiResid<false>, pg8::StaticOrder, true, true>(ldsl, g, S, E); } while (0)

#ifndef DUP_PH
#define DUP_PH (-1)
#endif
#define PHASE_CTX Ctx C = C0; { int t_ = threadIdx.x; asm volatile("" : "+v"(t_)); C.tid = t_; C.lane = t_ & 63; }
#define PHASE(k, ...) do { if (IN(k)) { PHASE_CTX __VA_ARGS__ } SEAM(k); if (DUP_PH == (k) && IN(k)) { PHASE_CTX __VA_ARGS__ xcd_barrier(bar); } } while (0)
#define PHASE_LAST(k, ...) do { if (IN(k)) { PHASE_CTX __VA_ARGS__ } } while (0)
    PHASE(0, prologue_phase(args, C, ldsl););
#define TAIL(first, lo_, hi_) do { const int f_ = (C.G == 256) ? (first) : 0;     \
        if (C.bid >= f_) convert_range(args, ws, (lo_), (hi_), (C.bid - f_) * NWAVES + C.wave, (C.G - f_) * NWAVES, C.lane); } while (0)
    PHASE(1, GEMM_GU(0, XN); TAIL(192, T1_LO, T1_HI););
    PHASE(2, GEMM_DOWN_X(0, args.in[0]););
    PHASE(4, pg8::Gemm g{H, (const bf16*)(ws + WS_WIN0), M, NP0, D, D, 0, 0}; pg8::StaticOrder S; S.init(M, NP0, C.G, C.bid); PREP_RS();
        pg8::EpiProj E{PROJ, NP0, E_FG / 256, (float*)(ws + WS_FG), 16, 16, 0, RSC}; pg8::gemm_phase<pg8::EpiProj, pg8::StaticOrder, true, true>(ldsl, g, S, E); TAIL(32, T4_LO, T4_HI););
    PHASE(5, even_post_phase(args, C););
    PHASE(6, MkFox mf{PROJ, MIX, (const float*)(ws + WS_CUM), (const float*)(ws + WS_NMAX)};
        att::attn_stream<1, false, att::bf16, NP0, NP0, NP0, D>((char*)lds, T, CAUSAL_W, BATCH * 16, C.G, XCD_DEAL(C.bid, C.G), mf);
        MkDiff md{PROJ, (att::bf16*)(ws + WS_SCR), (att::bf16*)(ws + WS_SCR) + (size_t)M * 2048};
        att::attn_stream<0, false, att::bf16, NP0, NP0, NP0, 2048>((char*)lds, T, CAUSAL_W, BATCH * 32, C.G, XCD_DEAL(C.bid, C.G), md););
    PHASE(7, even_combine_phase(args, C););
    PHASE(8, GEMM_OUT(WS_WOUT0););
    PHASE(10, GEMM_GU(1, H); TAIL(192, T10_LO, T10_HI););
    PHASE(11, GEMM_DOWN(1, H););
    PHASE(13, GEMM_GU(2, H); TAIL(192, T13_LO, T13_HI););
    PHASE(14, GEMM_DOWN(2, H););
    PHASE(16, pg8::Gemm g{H, (const bf16*)(ws + WS_WIN1), M, NP1, D, D, 0, 0}; pg8::StaticOrder S; S.init(M, NP1, C.G, C.bid); PREP_RS();
        pg8::EpiProj E{PROJ, NP1, O_GT / 256, (float*)(ws + WS_GATES), 96, 96, 1, RSC}; pg8::gemm_phase<pg8::EpiProj, pg8::StaticOrder, true, true>(ldsl, g, S, E); TAIL(160, T16_LO, T16_HI););
    PHASE(17, odd_post_phase(args, C););
    PHASE(18, pg8::Gemm g{(const bf16*)(ws + WS_ACMP), (const bf16*)(ws + WS_W1C), 4096, 512, 4096, 4096, 0, 0}; pg8::CmpOrder S{C.bid};
        pg8::EpiCmp E{(bf16*)(ws + WS_HIDC), (const float*)(ws + WS_CB)}; pg8::gemm_phase<pg8::EpiCmp, pg8::CmpOrder, true, true>(ldsl, g, S, E);
        { att::bf16* owin = (att::bf16*)(ws + WS_SCR) + (size_t)2 * M * D;
            MkNsa mw{(const bf16*)(ws + WS_QROT), PROJ, owin, (const unsigned*)(ws + WS_SELM), O_KW, O_VW, (const bf16*)(ws + WS_SCR), (const float*)(ws + WS_GATES)};
            const int skipw = C.G > 32 ? 16 : 0;
            if (C.bid >= skipw) att::attn_stream<0, true, att::bf16, D, NP1, NP1, D>((char*)lds, T, WINDOW, BATCH * 32, C.G - skipw, XCD_DEAL(C.bid - skipw, C.G - skipw), mw); });
    PHASE(19, cmp2_phase(args, C););
    PHASE(20, cmp_attn_phase(C, (char*)lds););
    PHASE(21, MkNsa ms{(const bf16*)(ws + WS_QROT), PROJ, (att::bf16*)MIX, (const unsigned*)(ws + WS_SELM), O_KS, O_VS, (const bf16*)(ws + WS_SCR), (const float*)(ws + WS_GATES)};
        att::attn_stream<2, false, att::bf16, D, NP1, NP1, D>((char*)lds, T, CAUSAL_W, BATCH * 32, C.G, XCD_DEAL(C.bid, C.G), ms););
    PHASE(23, GEMM_OUT(WS_WOUT1););
    PHASE(25, GEMM_GU(3, H); TAIL(192, T25_LO, T25_HI););
    PHASE(26, GEMM_DOWN(3, H););
    PHASE_LAST(27, final_norm_phase(C, H, args.in[28], C.out););
#undef IN
#undef SEAM
}

#ifndef MK_SPLIT
#define MK_SPLIT 0
#endif
extern "C" void kernel_launch(void* const* d_in, const int* in_sizes, int n_in, void* d_out, int out_size, void* d_ws, size_t ws_size, hipStream_t stream) {
    static int grid = 0;
    if (grid == 0) {
        if (n_in != 29 || out_size != M * D || ws_size < WS_END) { fprintf(stderr, "kernel_launch: unexpected shapes (n_in %d out %d ws %zu need %zu)\n", n_in, out_size, ws_size, (size_t)WS_END); grid = -1; return; }
        int dev = 0, cus = 0, per_cu = 0;
        if (hipGetDevice(&dev) != hipSuccess || hipDeviceGetAttribute(&cus, hipDeviceAttributeMultiprocessorCount, dev) != hipSuccess) { grid = -1; return; }
        if (hipFuncSetAttribute((const void*)hybrid_fwd, hipFuncAttributeMaxDynamicSharedMemorySize, LDS_BYTES) != hipSuccess) { fprintf(stderr, "kernel_launch: hipFuncSetAttribute failed\n"); grid = -1; return; }
        if (hipOccupancyMaxActiveBlocksPerMultiprocessor(&per_cu, (const void*)hybrid_fwd, NWAVES * 64, LDS_BYTES) != hipSuccess || per_cu < 1)
            fprintf(stderr, "kernel_launch: occupancy query reports %d workgroups per CU\n", per_cu);
        (void)hipGetLastError();
        grid = cus;
    }
    if (grid < 0) return;
    (void)hipMemsetAsync((char*)d_ws + WS_CTL, 0, CTL_ZERO_BYTES, stream);
    Args a{};
    for (int i = 0; i < 29; ++i) a.in[i] = (const float*)d_in[i];
    a.out = (float*)d_out; a.ws = (unsigned char*)d_ws;
#if MK_SPLIT
    for (int p = 0; p < NPH; ++p) { a.ph_lo = p; a.ph_hi = p + 1; hipLaunchKernelGGL(hybrid_fwd, dim3(grid), dim3(NWAVES * 64), LDS_BYTES, stream, a); }
#else
    a.ph_lo = 0; a.ph_hi = NPH; hipLaunchKernelGGL(hybrid_fwd, dim3(grid), dim3(NWAVES * 64), LDS_BYTES, stream, a);
#endif
}
```

```cpp
#include <hip/hip_runtime.h>
#include <hip/hip_bf16.h>
#include <cstdio>
#include <cstdint>

namespace pg8 {
#define PG8_LAS __attribute__((address_space(3)))
typedef unsigned short bf16_t;
typedef short bf16x8 __attribute__((ext_vector_type(8)));
typedef float f32x4 __attribute__((ext_vector_type(4)));
typedef unsigned u32x4 __attribute__((ext_vector_type(4)));
constexpr int BM = 256, BK = 64, HALF = 128, HTB = HALF * BK * 2  , STAGE_BYTES = 8 * HTB, NXCD = 8, WGM = 4;

__host__ __device__ __forceinline__ int lds_byte(int r, int c) { const int st = (r >> 4) * 2 + (c >> 5), rr = r & 15, cc = c & 31, ob = rr * 64 + cc * 2; return st * 1024 + (ob ^ (((ob >> 9) & 1) << 5)); }
__host__ __device__ __forceinline__ void stage_rc(int b, int& R, int& C) { const int st = b / 1024, sb = b % 1024, swz = sb ^ (((sb >> 9) & 1) << 5); R = (st >> 1) * 16 + swz / 64; C = (st & 1) * 32 + (swz % 64) / 2; }
__host__ __device__ __forceinline__ int perm32(int rho) { const int n = rho >> 4, i = rho & 15; return 8 * (i >> 2) + 4 * n + (i & 3); }

struct Unit { int pm, pn; };
struct Gemm { const bf16_t* A; const bf16_t* Bt; int M, N, K, ld, tiledA, tiledB; };

struct StaticOrder {
    int nM, nN, nwg, G, c;
    __host__ __device__ __forceinline__ void init(int M, int N, int G_, int c_) { nM = M / BM; nN = N / BM; nwg = nM * nN; G = G_; c = c_; }
    __host__ __device__ __forceinline__ bool next(int i, Unit& u) const {
        const long L = (long)i * G + c; if (L >= nwg) return false;
        int wgid = (int)L; { const int q = nwg / NXCD, r = nwg % NXCD, xcd = wgid % NXCD, off = wgid / NXCD; wgid = (xcd < r ? xcd * (q + 1) : r * (q + 1) + (xcd - r) * q) + off; }
        const int nig = WGM * nN, gid = wgid / nig, fm = gid * WGM, gsz = (nM - fm) < WGM ? (nM - fm) : WGM;
        u.pm = fm + ((wgid % nig) % gsz); u.pn = (wgid % nig) / gsz; return true;
    }
    __device__ __forceinline__ void a_ready(const Unit&) const {}
    __device__ __forceinline__ void done(const Unit&) const {}
};
struct CmpOrder {
    int c;
    __device__ __forceinline__ bool next(int i, Unit& u) const { if (i != 0 || c >= 16) return false; u.pm = c; u.pn = c >> 3; return true; }
    __device__ __forceinline__ void a_ready(const Unit&) const {}
    __device__ __forceinline__ void done(const Unit&) const {}
};

__device__ __forceinline__ unsigned cvt_pk_bf16(float lo, float hi) { unsigned r; asm volatile("v_cvt_pk_bf16_f32 %0, %1, %2" : "=v"(r) : "v"(lo), "v"(hi)); return r; }
__device__ __forceinline__ float silu_f(float x) { return x * __builtin_amdgcn_rcpf(1.0f + __builtin_amdgcn_exp2f(-1.4426950408889634f * x)); }
__device__ __forceinline__ float sigmoid_f(float x) { return __builtin_amdgcn_rcpf(1.0f + __builtin_amdgcn_exp2f(-1.4426950408889634f * x)); }


struct RowScale {
    const PG8_LAS float* rs; int pm0; const float* part; float inv_n, eps;
    __device__ __forceinline__ float get(const Unit& u, int lr) const {
        if (u.pm == pm0) return rs[lr];
        const f32x4* p = (const f32x4*)(part + ((size_t)u.pm * BM + lr) * 64); f32x4 a = p[0];
        for (int i = 1; i < 16; ++i) a += p[i];
        return 1.0f / sqrtf(((a[0] + a[1]) + (a[2] + a[3])) * inv_n + eps);
    }
};
struct EpiSwiGLU {
    static constexpr bool PERM = true, AFTER_DRAIN = false;
    bf16_t* O; int ldc; RowScale R;
    __device__ __forceinline__ void operator()(const f32x4 (&acc)[2][2][4][2], const Unit& u, int wr, int wc, int fr, int fq) const {
        const int row0 = u.pm * BM + wr * 64 + fr, col0 = u.pn * HALF + wc * 32 + 8 * fq;
#pragma unroll
        for (int ai = 0; ai < 2; ++ai)
#pragma unroll
            for (int m = 0; m < 4; ++m) { bf16_t* rowp = O + ((size_t)(col0 >> 6) * ldc + (row0 + ai * HALF + m * 16)) * 64 + (col0 & 63);
                const float rsc = R.get(u, wr * 64 + fr + ai * HALF + m * 16);
                const f32x4 g0 = acc[ai][0][m][0] * rsc, g1 = acc[ai][0][m][1] * rsc, u0 = acc[ai][1][m][0] * rsc, u1 = acc[ai][1][m][1] * rsc;
                f32x4 h0, h1;
#pragma unroll
                for (int e = 0; e < 4; ++e) { h0[e] = silu_f(g0[e]) * u0[e]; h1[e] = silu_f(g1[e]) * u1[e]; }
                u32x4 w; w.x = cvt_pk_bf16(h0[0], h0[1]); w.y = cvt_pk_bf16(h0[2], h0[3]); w.z = cvt_pk_bf16(h1[0], h1[1]); w.w = cvt_pk_bf16(h1[2], h1[3]);
                *(u32x4*)rowp = w; }
    }
};
template <bool BASE_F32> struct EpiResid {
    static constexpr bool PERM = true, AFTER_DRAIN = false;
    const void* base; bf16_t* out; int ldc; float alpha; float* part;
    __device__ __forceinline__ void operator()(const f32x4 (&acc)[2][2][4][2], const Unit& u, int wr, int wc, int fr, int fq) const {
        const int row0 = u.pm * BM + wr * 64 + fr, col0 = u.pn * BM + wc * 32 + 8 * fq;
#pragma unroll
        for (int ai = 0; ai < 2; ++ai) {
            f32x4 b0[4][2], b1[4][2];
#pragma unroll
            for (int m = 0; m < 4; ++m) { const size_t off = (size_t)(row0 + ai * HALF + m * 16) * ldc + col0;
#pragma unroll
                for (int bj = 0; bj < 2; ++bj) {
                    if constexpr (BASE_F32) { const float* bp = (const float*)base + off + bj * HALF; b0[m][bj] = *(const f32x4*)bp; b1[m][bj] = *(const f32x4*)(bp + 4); }
                    else { const u32x4 w = *(const u32x4*)((const bf16_t*)base + off + bj * HALF);
                        b0[m][bj] = (f32x4){__builtin_bit_cast(float, w.x << 16), __builtin_bit_cast(float, w.x & 0xffff0000u), __builtin_bit_cast(float, w.y << 16), __builtin_bit_cast(float, w.y & 0xffff0000u)};
                        b1[m][bj] = (f32x4){__builtin_bit_cast(float, w.z << 16), __builtin_bit_cast(float, w.z & 0xffff0000u), __builtin_bit_cast(float, w.w << 16), __builtin_bit_cast(float, w.w & 0xffff0000u)}; } } }
#pragma unroll
            for (int m = 0; m < 4; ++m) { const int row = row0 + ai * HALF + m * 16; const size_t off = (size_t)row * ldc + col0; float ss = 0.f;
#pragma unroll
                for (int bj = 0; bj < 2; ++bj) { const f32x4 v0 = b0[m][bj] + acc[ai][bj][m][0] * alpha, v1 = b1[m][bj] + acc[ai][bj][m][1] * alpha;
                    u32x4 w; w.x = cvt_pk_bf16(v0[0], v0[1]); w.y = cvt_pk_bf16(v0[2], v0[3]); w.z = cvt_pk_bf16(v1[0], v1[1]); w.w = cvt_pk_bf16(v1[2], v1[3]);
                    *(u32x4*)(out + off + bj * HALF) = w;
#pragma unroll
                    for (int e = 0; e < 4; ++e) { const unsigned ww = e == 0 ? w.x : e == 1 ? w.y : e == 2 ? w.z : w.w; const float lo = __builtin_bit_cast(float, ww << 16), hi = __builtin_bit_cast(float, ww & 0xffff0000u); ss += lo * lo + hi * hi; } }
                if (part) { ss += __shfl_xor(ss, 16); ss += __shfl_xor(ss, 32); if (fq == 0) part[(size_t)row * 64 + u.pn * 4 + wc] = ss; } }
            asm volatile("" ::: "memory"); }
    }
};
struct EpiProj {
    static constexpr bool PERM = true, AFTER_DRAIN = false;
    bf16_t* O; int ldc; int sp_pn; float* side; int side_ld; int side_n; int side_sig; RowScale R;
    __device__ __forceinline__ void operator()(const f32x4 (&acc)[2][2][4][2], const Unit& u, int wr, int wc, int fr, int fq) const {
        const int row0 = u.pm * BM + wr * 64 + fr, col0 = u.pn * BM + wc * 32 + 8 * fq;
        if (u.pn == sp_pn) {
#pragma unroll
            for (int ai = 0; ai < 2; ++ai)
#pragma unroll
                for (int m = 0; m < 4; ++m) { const int row = row0 + ai * HALF + m * 16; const float rsc = R.get(u, wr * 64 + fr + ai * HALF + m * 16);
#pragma unroll
                    for (int bj = 0; bj < 2; ++bj) { const int cl = bj * HALF + wc * 32 + 8 * fq;
                        if (cl < side_n) { f32x4 v0 = acc[ai][bj][m][0] * rsc, v1 = acc[ai][bj][m][1] * rsc;
                            if (side_sig) {
#pragma unroll
                                for (int e = 0; e < 4; ++e) { v0[e] = sigmoid_f(v0[e]); v1[e] = sigmoid_f(v1[e]); } }
                            float* sp = side + (size_t)row * side_ld + cl; *(f32x4*)sp = v0; *(f32x4*)(sp + 4) = v1; } } }
            return;
        }
#pragma unroll
        for (int ai = 0; ai < 2; ++ai)
#pragma unroll
            for (int m = 0; m < 4; ++m) { bf16_t* rowp = O + (size_t)(row0 + ai * HALF + m * 16) * ldc + col0; const float rsc = R.get(u, wr * 64 + fr + ai * HALF + m * 16);
#pragma unroll
                for (int bj = 0; bj < 2; ++bj) { const f32x4 v0 = acc[ai][bj][m][0] * rsc, v1 = acc[ai][bj][m][1] * rsc;
                    u32x4 w; w.x = cvt_pk_bf16(v0[0], v0[1]); w.y = cvt_pk_bf16(v0[2], v0[3]); w.z = cvt_pk_bf16(v1[0], v1[1]); w.w = cvt_pk_bf16(v1[2], v1[3]);
                    *(u32x4*)(rowp + bj * HALF) = w; } }
    }
};
struct EpiCmp {
    static constexpr bool PERM = true, AFTER_DRAIN = false;
    bf16_t* O; const float* bias;
    __device__ __forceinline__ void operator()(const f32x4 (&acc)[2][2][4][2], const Unit& u, int wr, int wc, int fr, int fq) const {
        const int row0 = u.pm * BM + wr * 64 + fr, cl0 = wc * 32 + 8 * fq;
        f32x4 bv[2][2];
#pragma unroll
        for (int bj = 0; bj < 2; ++bj)
#pragma unroll
            for (int n = 0; n < 2; ++n) bv[bj][n] = *(const f32x4*)(bias + u.pn * BM + cl0 + bj * HALF + 4 * n);
#pragma unroll
        for (int ai = 0; ai < 2; ++ai)
#pragma unroll
            for (int m = 0; m < 4; ++m) { bf16_t* rowp = O + (size_t)(row0 + ai * HALF + m * 16) * 256 + cl0;
#pragma unroll
                for (int bj = 0; bj < 2; ++bj) { f32x4 v0 = acc[ai][bj][m][0] + bv[bj][0], v1 = acc[ai][bj][m][1] + bv[bj][1];
#pragma unroll
                    for (int e = 0; e < 4; ++e) { v0[e] = silu_f(v0[e]); v1[e] = silu_f(v1[e]); }
                    u32x4 w; w.x = cvt_pk_bf16(v0[0], v0[1]); w.y = cvt_pk_bf16(v0[2], v0[3]); w.z = cvt_pk_bf16(v1[0], v1[1]); w.w = cvt_pk_bf16(v1[2], v1[3]);
                    *(u32x4*)(rowp + bj * HALF) = w; } }
    }
};

template <class Epi, class Sched, bool ALIGN_EPI = false, bool SP2 = false>
__device__ __forceinline__ void gemm_phase(PG8_LAS unsigned char* lds, const Gemm g, const Sched& S, const Epi& E) {
    int tid_ = threadIdx.x; asm volatile("" : "+v"(tid_));
    const int tid = tid_, wid = __builtin_amdgcn_readfirstlane(tid >> 6), lane = tid & 63, wr = wid >> 2, wc = wid & 3, fr = lane & 15, fq = lane >> 4;
    const int K = g.ld, nt = g.K / BK;
    const unsigned rpA = g.tiledA ? 128u : (unsigned)K * 2u, rpB = g.tiledB ? 128u : (unsigned)K * 2u;
    unsigned voffA[2], voffB[2];
#pragma unroll
    for (int i = 0; i < 2; ++i) { int R, C; stage_rc(tid * 16 + i * 8192, R, C); const int Rb = Epi::PERM ? ((R & ~31) + perm32(R & 31)) : R;
        voffA[i] = (unsigned)R * rpA + (unsigned)C * 2u; voffB[i] = (unsigned)Rb * rpB + (unsigned)C * 2u; }
    const size_t kstepA = g.tiledA ? (size_t)g.M * 128 : (size_t)(BK * 2), kstepB = g.tiledB ? (size_t)g.N * 128 : (size_t)(BK * 2);
    const size_t hstepA = (size_t)HALF * rpA, hstepB = (size_t)HALF * rpB;
    const size_t tstepA = 2 * hstepA, tstepB = 2 * hstepB;
    const unsigned ldsw = (unsigned)wid * 1024u;
    const int aoff = lds_byte(wr * 64 + fr, fq * 8), boff = lds_byte(wc * 32 + fr, fq * 8);
#define PG8_SA(b, h) (((b) * 2 + (h)) * HTB)
#define PG8_SB(b, h) ((4 + (b) * 2 + (h)) * HTB)
#define PG8_STAGE(bufoff, gbase, voff) do { _Pragma("unroll") for (int _i = 0; _i < 2; ++_i) \
        __builtin_amdgcn_global_load_lds((const unsigned*)((const char*)(gbase) + (voff)[_i]), (PG8_LAS unsigned*)(lds + (bufoff) + ldsw + _i * 8192), 16, 0, 0); } while (0)
#define PG8_LDA(dst, b, h) do { _Pragma("unroll") for (int m = 0; m < 4; ++m) _Pragma("unroll") for (int k = 0; k < 2; ++k) dst[m][k] = *(const PG8_LAS bf16x8*)(lds + PG8_SA(b, h) + aoff + m * 2048 + k * 1024); } while (0)
#define PG8_LDB(dst, b, h) do { _Pragma("unroll") for (int n = 0; n < 2; ++n) _Pragma("unroll") for (int k = 0; k < 2; ++k) dst[n][k] = *(const PG8_LAS bf16x8*)(lds + PG8_SB(b, h) + boff + n * 2048 + k * 1024); } while (0)
#define PG8_MMA(ai, bj, At, Bt) do { __builtin_amdgcn_s_setprio(1); _Pragma("unroll") for (int m = 0; m < 4; ++m) _Pragma("unroll") for (int n = 0; n < 2; ++n) _Pragma("unroll") for (int k = 0; k < 2; ++k) \
        acc[ai][bj][m][n] = __builtin_amdgcn_mfma_f32_16x16x32_bf16(Bt[n][k], At[m][k], acc[ai][bj][m][n], 0, 0, 0); __builtin_amdgcn_s_setprio(0); } while (0)
#define PG8_WAIT_V(n) asm volatile("s_waitcnt vmcnt(" #n ")" ::: "memory")
#define PG8_WAIT_L(n) asm volatile("s_waitcnt lgkmcnt(" #n ")" ::: "memory")
#define PG8_BAR __builtin_amdgcn_s_barrier()
#define PG8_SCHED __builtin_amdgcn_sched_barrier(0)
    Unit cur, nxt; int ui = 0;
    if (!S.next(0, cur)) return;
    f32x4 acc[2][2][4][2];
#pragma unroll
    for (int a = 0; a < 2; ++a)
#pragma unroll
        for (int b = 0; b < 2; ++b)
#pragma unroll
            for (int m = 0; m < 4; ++m)
#pragma unroll
                for (int n = 0; n < 2; ++n) acc[a][b][m][n] = (f32x4){0.f, 0.f, 0.f, 0.f};
    bf16x8 At[4][2], B0[2][2], B1[2][2];
    const char* cA = (const char*)g.A + (size_t)cur.pm * tstepA; const char* cB = (const char*)g.Bt + (size_t)cur.pn * tstepB;
    S.a_ready(cur);
    if constexpr (SP2) {
        PG8_STAGE(PG8_SB(0, 0), cB, voffB); PG8_STAGE(PG8_SB(0, 1), cB + hstepB, voffB); PG8_STAGE(PG8_SA(0, 0), cA, voffA); PG8_STAGE(PG8_SA(0, 1), cA + hstepA, voffA);
        if (wr == 1) PG8_BAR;
        PG8_WAIT_V(2); PG8_BAR;
        PG8_STAGE(PG8_SB(1, 0), cB + kstepB, voffB); PG8_STAGE(PG8_SA(1, 0), cA + kstepA, voffA); PG8_STAGE(PG8_SB(1, 1), cB + hstepB + kstepB, voffB);
        PG8_WAIT_V(6); PG8_BAR;
    } else {
        PG8_STAGE(PG8_SB(0, 0), cB, voffB); PG8_STAGE(PG8_SA(0, 0), cA, voffA); PG8_STAGE(PG8_SB(0, 1), cB + hstepB, voffB); PG8_STAGE(PG8_SA(0, 1), cA + hstepA, voffA);
        if (wr == 1) PG8_BAR;
        PG8_WAIT_V(4); PG8_BAR;
        PG8_STAGE(PG8_SB(1, 0), cB + kstepB, voffB); PG8_STAGE(PG8_SA(1, 0), cA + kstepA, voffA); PG8_STAGE(PG8_SB(1, 1), cB + hstepB + kstepB, voffB);
        PG8_WAIT_V(6); PG8_BAR;
    }
    for (;;) {
        const bool has_next = S.next(ui + 1, nxt);
        const char* nA = has_next ? (const char*)g.A + (size_t)nxt.pm * tstepA : cA; const char* nB = has_next ? (const char*)g.Bt + (size_t)nxt.pn * tstepB : cB;
        for (int t = 0; t < nt; t += 2) {
            const bool last = (t == nt - 2);
            const char* a1 = cA + (size_t)(t + 1) * kstepA;
            const char* a2 = last ? nA : cA + (size_t)(t + 2) * kstepA; const char* b2 = last ? nB : cB + (size_t)(t + 2) * kstepB;
            const char* a3 = a2 + kstepA; const char* b3 = b2 + kstepB;
            if (last && has_next) S.a_ready(nxt);
            if constexpr (SP2) {
            PG8_LDB(B0, 0, 0); PG8_LDB(B1, 0, 1); PG8_SCHED; PG8_LDA(At, 0, 0); PG8_STAGE(PG8_SA(1, 1), a1 + hstepA, voffA);
            PG8_WAIT_V(8); PG8_WAIT_L(0); PG8_BAR; PG8_MMA(0, 0, At, B0); PG8_MMA(0, 1, At, B1); PG8_BAR; PG8_SCHED;
            PG8_LDA(At, 0, 1); PG8_STAGE(PG8_SB(0, 0), b2, voffB); PG8_STAGE(PG8_SB(0, 1), b2 + hstepB, voffB); PG8_STAGE(PG8_SA(0, 0), a2, voffA);
            PG8_WAIT_V(8); PG8_WAIT_L(0); PG8_BAR; PG8_MMA(1, 0, At, B0); PG8_MMA(1, 1, At, B1); PG8_BAR; PG8_SCHED;
            PG8_LDB(B0, 1, 0); PG8_LDB(B1, 1, 1); PG8_SCHED; PG8_LDA(At, 1, 0); PG8_STAGE(PG8_SA(0, 1), a2 + hstepA, voffA);
            PG8_WAIT_V(8); PG8_WAIT_L(0); PG8_BAR; PG8_MMA(0, 0, At, B0); PG8_MMA(0, 1, At, B1); PG8_BAR; PG8_SCHED;
            PG8_LDA(At, 1, 1); PG8_STAGE(PG8_SB(1, 0), b3, voffB); PG8_STAGE(PG8_SB(1, 1), b3 + hstepB, voffB); PG8_STAGE(PG8_SA(1, 0), a3, voffA);
            PG8_WAIT_V(8); PG8_WAIT_L(0); PG8_BAR; PG8_MMA(1, 0, At, B0); PG8_MMA(1, 1, At, B1); PG8_BAR; PG8_SCHED;
            } else {
            PG8_LDB(B0, 0, 0); PG8_SCHED; PG8_LDA(At, 0, 0); PG8_STAGE(PG8_SA(1, 1), a1 + hstepA, voffA);
            PG8_WAIT_L(8); PG8_BAR; PG8_WAIT_L(0); PG8_MMA(0, 0, At, B0); PG8_BAR; PG8_SCHED;
            PG8_LDB(B1, 0, 1); PG8_STAGE(PG8_SB(0, 0), b2, voffB);
            PG8_BAR; PG8_WAIT_L(0); PG8_MMA(0, 1, At, B1); PG8_BAR;
            PG8_LDA(At, 0, 1); PG8_STAGE(PG8_SA(0, 0), a2, voffA);
            PG8_BAR; PG8_WAIT_L(0); PG8_MMA(1, 0, At, B0); PG8_BAR; PG8_SCHED;
            PG8_STAGE(PG8_SB(0, 1), b2 + hstepB, voffB);
            PG8_WAIT_V(6); PG8_BAR; PG8_MMA(1, 1, At, B1); PG8_BAR;
            PG8_LDB(B0, 1, 0); PG8_SCHED; PG8_LDA(At, 1, 0); PG8_STAGE(PG8_SA(0, 1), a2 + hstepA, voffA);
            PG8_WAIT_L(8); PG8_BAR; PG8_WAIT_L(0); PG8_MMA(0, 0, At, B0); PG8_BAR; PG8_SCHED;
            PG8_LDB(B1, 1, 1); PG8_STAGE(PG8_SB(1, 0), b3, voffB);
            PG8_BAR; PG8_WAIT_L(0); PG8_MMA(0, 1, At, B1); PG8_BAR;
            PG8_LDA(At, 1, 1); PG8_STAGE(PG8_SA(1, 0), a3, voffA);
            PG8_BAR; PG8_WAIT_L(0); PG8_MMA(1, 0, At, B0); PG8_BAR; PG8_SCHED;
            PG8_STAGE(PG8_SB(1, 1), b3 + hstepB, voffB);
            PG8_WAIT_V(6); PG8_BAR; PG8_MMA(1, 1, At, B1); PG8_BAR;
            }
        }
        if constexpr (ALIGN_EPI) { if (wr == 0) PG8_BAR; }
        if constexpr (!Epi::AFTER_DRAIN) { E(acc, cur, wr, wc, fr, fq); S.done(cur); }
        if (!has_next) break;
#pragma unroll
        for (int a = 0; a < 2; ++a)
#pragma unroll
            for (int b = 0; b < 2; ++b)
#pragma unroll
                for (int m = 0; m < 4; ++m)
#pragma unroll
                    for (int n = 0; n < 2; ++n) acc[a][b][m][n] = (f32x4){0.f, 0.f, 0.f, 0.f};
        cur = nxt; cA = nA; cB = nB; ++ui;
        if constexpr (ALIGN_EPI) { if (wr == 1) PG8_BAR; }
    }
    PG8_WAIT_V(0);
    if constexpr (!ALIGN_EPI) { if (wr == 0) PG8_BAR; }
    PG8_BAR;
    if constexpr (Epi::AFTER_DRAIN) { E.fused(acc, cur, wr, wc, fr, fq, lds, wid, lane); S.done(cur); }
#undef PG8_SA
#undef PG8_SB
#undef PG8_STAGE
#undef PG8_LDA
#undef PG8_LDB
#undef PG8_MMA
#undef PG8_WAIT_V
#undef PG8_WAIT_L
#undef PG8_BAR
#undef PG8_SCHED
}
}

#define XB_TMO      128
#define XB_XCNT(j)  (256  + 64 * (j))
#define XB_XSUB(j)  (1280 + 64 * (j))
#define XB_XGEN(j)  (2304 + 64 * (j))
#define XB_TOP      3328
#define XB_TOPGEN   3392
#define XCD_BAR_WORDS 3456
#define XB_SPIN_CAP (1u << 18)
#define LAS __attribute__((address_space(3)))

__device__ __forceinline__ unsigned xb_ld(unsigned* p)              { return __hip_atomic_load(p, __ATOMIC_RELAXED, __HIP_MEMORY_SCOPE_AGENT); }
__device__ __forceinline__ unsigned xb_add(unsigned* p, unsigned v) { return __hip_atomic_fetch_add(p, v, __ATOMIC_RELAXED, __HIP_MEMORY_SCOPE_AGENT); }
__device__ __forceinline__ unsigned xb_xcc_id() { return (unsigned)__builtin_amdgcn_s_getreg((3 << 11) | 20) & 0xFu; }
#define XB_SPIN(cond, bar) do { unsigned _sp = 0; while (cond) { __builtin_amdgcn_s_sleep(1); \
    if ((++_sp & 255u) == 0u) { if (xb_ld(&(bar)[XB_TMO])) break; if (_sp > XB_SPIN_CAP) { atomicAdd(&(bar)[XB_TMO], 1u); break; } } } } while (0)

struct XcdBarrier {
    unsigned* bar; unsigned x;
    volatile LAS unsigned* st;
};
__device__ __forceinline__ XcdBarrier xcd_barrier_post(unsigned* bar, volatile LAS unsigned* st) {
    XcdBarrier b; b.bar = bar; b.x = xb_xcc_id(); b.st = st;
    if (threadIdx.x == 0) (void)xb_add(&bar[XB_XCNT(b.x)], 1u);
    return b;
}
__device__ __forceinline__ void xcd_barrier_complete(unsigned* bar, unsigned x, unsigned& nloc, unsigned& nx) {
    const unsigned G = gridDim.x * gridDim.y * gridDim.z;
    unsigned sum, cnt, mine, sp = 0u;
    for (;;) {
        sum = 0u; cnt = 0u; mine = 0u;
#pragma unroll
        for (unsigned j = 0; j < 16; ++j) { const unsigned c = xb_ld(&bar[XB_XCNT(j)]); sum += c; cnt += (c > 0u) ? 1u : 0u; mine = (j == x) ? c : mine; }
        if (sum == G) break;
        __builtin_amdgcn_s_sleep(1);
        if ((++sp & 255u) == 0u) { if (xb_ld(&bar[XB_TMO])) break; if (sp > XB_SPIN_CAP) { atomicAdd(&bar[XB_TMO], 1u); break; } }
    }
    nloc = mine > 0u ? mine : 1u; nx = cnt > 0u ? cnt : 1u;
}
__device__ __forceinline__ void xcd_barrier(const XcdBarrier& b) {
    asm volatile("s_waitcnt vmcnt(0)" ::: "memory");
    __syncthreads();
    if (threadIdx.x == 0) {
        unsigned* bar = b.bar;
        __builtin_amdgcn_s_waitcnt(0);
        unsigned nloc = b.st[0], nx = b.st[1];
        if (nloc == 0u) { xcd_barrier_complete(bar, b.x, nloc, nx); b.st[0] = nloc; b.st[1] = nx; }
        const unsigned old = xb_add(&bar[XB_XSUB(b.x)], 1u);
        const unsigned gen = old / nloc;
        if (old + 1u == (gen + 1u) * nloc) {
            __builtin_amdgcn_fence(__ATOMIC_RELEASE, "agent");
            asm volatile("s_waitcnt vmcnt(0)" ::: "memory");
            const unsigned og = xb_add(&bar[XB_TOP], 1u);
            const unsigned tg = og / nx;
            if (og + 1u == (tg + 1u) * nx) xb_add(&bar[XB_TOPGEN], 1u);
            else XB_SPIN(xb_ld(&bar[XB_TOPGEN]) == tg, bar);
            __builtin_amdgcn_fence(__ATOMIC_ACQUIRE, "agent");
            xb_add(&bar[XB_XGEN(b.x)], 1u);
            asm volatile("s_waitcnt vmcnt(0)" ::: "memory");
        } else {
            XB_SPIN(xb_ld(&bar[XB_XGEN(b.x)]) == gen, bar);
            __builtin_amdgcn_fence(__ATOMIC_ACQUIRE, "agent");
            asm volatile("s_waitcnt vmcnt(0)" ::: "memory");
        }
    }
    __syncthreads();
}

namespace att {
enum { ORDER_PAIRED = 2 };
constexpr int HD = 128;
constexpr float THR = 8.f;
constexpr float SCALE = 0.08838834764831845f;
constexpr float ISCALE = 11.313708498984761f;
constexpr int NW = 8, QBLK = 32, KVBLK = 64, QB = NW * QBLK;
constexpr int SHM_V = KVBLK * HD * 2, SHM_K = KVBLK * HD * 2;
constexpr int LDS_BYTES = 2 * SHM_V + 2 * SHM_K + NW * 64 * 4;
using bf16 = __hip_bfloat16;
typedef short bf16x8 __attribute__((ext_vector_type(8)));
typedef short s16x4 __attribute__((ext_vector_type(4)));
typedef float f32x16 __attribute__((ext_vector_type(16)));
typedef float f32x4 __attribute__((ext_vector_type(4)));
typedef unsigned u32x4 __attribute__((ext_vector_type(4)));
template <class A, class Bt> struct same_t { static constexpr bool v = false; };
template <class A> struct same_t<A, A> { static constexpr bool v = true; };

#define KSWZ(row, colB) ((row) * 256 + ((colB) ^ (((row) & 7) << 4)))
#define SBAR() __builtin_amdgcn_sched_barrier(0)
__device__ __forceinline__ int v_st(int k, int c) { const int kk = (k & ~0xC) | ((k & 4) << 1) | ((k & 8) >> 1); return ((kk >> 3) * 4 + (c >> 5)) * 512 + ((kk & 7) * 32 + (c & 31)) * 2; }
__device__ __forceinline__ int v_rd_base(int lane) { return ((lane & 3) << 3) | (((lane >> 2) & 3) << 6) | (((lane >> 4) & 1) << 5) | (((lane >> 5) & 1) << 8); }
constexpr int v_rd_off(int d0, int ks, int half) { return d0 * 512 + ks * 4096 + half * 2048; }
__device__ __forceinline__ int crow(int r, int hi) { return (r & 3) + 8 * (r >> 2) + 4 * hi; }
__device__ __forceinline__ unsigned cvtpk(float lo, float hi) {
    unsigned r; asm volatile("v_cvt_pk_bf16_f32 %0, %1, %2" : "=v"(r) : "v"(lo), "v"(hi)); return r;
}
__device__ __forceinline__ bf16x8 load8(const bf16* p) { return *reinterpret_cast<const bf16x8*>(p); }
__device__ __forceinline__ void mask_tile(f32x16& p0, f32x16& p1, int dq, unsigned W) {
    const float NEG = -__builtin_inff();
#pragma unroll
    for (int r = 0; r < 16; ++r) {
        const int c = (r & 3) + 8 * (r >> 2);
        if ((unsigned)(dq - c) >= W) p0[r] = NEG;
        if ((unsigned)(dq - c - 32) >= W) p1[r] = NEG;
    }
}
__device__ __forceinline__ void fox_bias(f32x16& p0, f32x16& p1, float cq, const float* ck) {
#pragma unroll
    for (int g = 0; g < 4; ++g) { const f32x4 c0 = *(const f32x4*)(ck + 8 * g), c1 = *(const f32x4*)(ck + 32 + 8 * g);
#pragma unroll
        for (int e = 0; e < 4; ++e) { p0[4 * g + e] += (cq - c0[e]) * ISCALE; p1[4 * g + e] += (cq - c1[e]) * ISCALE; } }
}
__device__ __forceinline__ void partialSM(f32x16& p0, f32x16& p1, float& m_reg, float& mn, float& alpha) {
    float pmax = p0[0]; for (int r = 1; r < 16; ++r) pmax = fmaxf(pmax, p0[r]); for (int r = 0; r < 16; ++r) pmax = fmaxf(pmax, p1[r]);
    { auto rr = __builtin_amdgcn_permlane32_swap(__float_as_uint(pmax), __float_as_uint(pmax), false, false);
      pmax = fmaxf(__uint_as_float(rr[0]), __uint_as_float(rr[1])); }
    constexpr float C2 = 1.4426950408889634f * SCALE;
    if (__builtin_expect(__all((pmax - m_reg) * SCALE <= THR), 1)) { mn = m_reg; alpha = 1.f; }
    else { mn = fmaxf(m_reg, pmax); alpha = __builtin_amdgcn_exp2f((m_reg - mn) * C2); m_reg = mn; }
    const float mnL = -mn * C2;
    for (int r = 0; r < 16; ++r) p0[r] = fmaf(p0[r], C2, mnL); for (int r = 0; r < 16; ++r) p1[r] = fmaf(p1[r], C2, mnL);
    for (int r = 0; r < 16; ++r) p0[r] = __builtin_amdgcn_exp2f(p0[r]);
}
#define PK4(P, B_, OUT) do { unsigned a0 = cvtpk(P[B_+0], P[B_+1]), a1 = cvtpk(P[B_+2], P[B_+3]);                          \
        unsigned b0 = cvtpk(P[B_+4], P[B_+5]), b1 = cvtpk(P[B_+6], P[B_+7]);                                             \
        auto r0 = __builtin_amdgcn_permlane32_swap(a0, b0, false, false); auto r1 = __builtin_amdgcn_permlane32_swap(a1, b1, false, false); \
        u32x4 w = {r0[0], r1[0], r0[1], r1[1]}; OUT = *reinterpret_cast<bf16x8*>(&w); } while (0)
__device__ __forceinline__ void finishSM(f32x16& p0, f32x16& p1, float alpha, float& l_reg, bf16x8& pa0, bf16x8& pa1, bf16x8& pa2, bf16x8& pa3) {
    for (int r = 0; r < 16; ++r) p1[r] = __builtin_amdgcn_exp2f(p1[r]);
    float ps = 0; for (int r = 0; r < 16; ++r) ps += p0[r]; for (int r = 0; r < 16; ++r) ps += p1[r];
    { auto rr = __builtin_amdgcn_permlane32_swap(__float_as_uint(ps), __float_as_uint(ps), false, false);
      ps = __uint_as_float(rr[0]) + __uint_as_float(rr[1]); }
    l_reg = l_reg * alpha + ps;
    PK4(p0, 0, pa0); PK4(p0, 8, pa1); PK4(p1, 0, pa2); PK4(p1, 8, pa3);
}
template <int KB, bool SK>
__device__ __forceinline__ void qkt(f32x16& p0, f32x16& p1, const char* K_lds, int r32, int hi, const bf16x8* qr, bool act) {
    if (SK && !act) { const float NEG = -__builtin_inff();
#pragma unroll
        for (int r = 0; r < 16; ++r) { p0[r] = NEG; p1[r] = NEG; } return; }
    p0 = f32x16{}; p1 = f32x16{};
    const char* kb[4];
#pragma unroll
    for (int dd = 0; dd < 4; ++dd) kb[dd] = K_lds + KB * SHM_K + KSWZ(r32, (dd * 16 + hi * 8) * 2);
#pragma unroll
    for (int d0 = 0; d0 < 8; ++d0) { const char* a = kb[d0 & 3] + (d0 >> 2) * 128;
        bf16x8 b0 = *reinterpret_cast<const bf16x8*>(a);
        bf16x8 b1 = *reinterpret_cast<const bf16x8*>(a + 32 * 256);
        p0 = __builtin_amdgcn_mfma_f32_32x32x16_bf16(b0, qr[d0], p0, 0, 0, 0);
        p1 = __builtin_amdgcn_mfma_f32_32x32x16_bf16(b1, qr[d0], p1, 0, 0, 0); }
}
template <int VB, bool SK>
__device__ __forceinline__ void pv_tile(f32x16* o, int vb0, bf16x8 pa0, bf16x8 pa1, bf16x8 pa2, bf16x8 pa3, bool act) {
    if (SK && !act) return;
#define TRRD(dst, off) asm volatile("ds_read_b64_tr_b16 %0, %1 offset:%2" : "=&v"(dst) : "v"(vb0), "i"(off) : "memory")
#define PV_D0(d0) do { s16x4 l0, l1, l2, l3, h0, h1, h2, h3; constexpr int b_ = VB * SHM_V + v_rd_off(d0, 0, 0);   \
        TRRD(l0, b_); TRRD(h0, b_ + 2048); TRRD(l1, b_ + 4096); TRRD(h1, b_ + 6144); TRRD(l2, b_ + 8192); TRRD(h2, b_ + 10240); TRRD(l3, b_ + 12288); TRRD(h3, b_ + 14336); \
        asm volatile("s_waitcnt lgkmcnt(0)" ::: "memory"); SBAR();   \
        o[d0] = __builtin_amdgcn_mfma_f32_32x32x16_bf16(pa0, (bf16x8){l0[0], l0[1], l0[2], l0[3], h0[0], h0[1], h0[2], h0[3]}, o[d0], 0, 0, 0);   \
        o[d0] = __builtin_amdgcn_mfma_f32_32x32x16_bf16(pa1, (bf16x8){l1[0], l1[1], l1[2], l1[3], h1[0], h1[1], h1[2], h1[3]}, o[d0], 0, 0, 0);   \
        o[d0] = __builtin_amdgcn_mfma_f32_32x32x16_bf16(pa2, (bf16x8){l2[0], l2[1], l2[2], l2[3], h2[0], h2[1], h2[2], h2[3]}, o[d0], 0, 0, 0);   \
        o[d0] = __builtin_amdgcn_mfma_f32_32x32x16_bf16(pa3, (bf16x8){l3[0], l3[1], l3[2], l3[3], h3[0], h3[1], h3[2], h3[3]}, o[d0], 0, 0, 0); } while (0)
    PV_D0(0); PV_D0(1); PV_D0(2); PV_D0(3);
#undef PV_D0
#undef TRRD
}

template <class TOut> struct BlockRef { const bf16* Q; const bf16* K; const bf16* V; TOut* O; const void* X; const void* Y; const void* Z; int P0; int J0; };
struct Seam { bf16x8 qr[8]; bf16x8 st_v0, st_v1, st_k0, st_k1; };
__device__ __forceinline__ int swa_jlo(int P0, int W) { const int lowk = P0 - W + 1; return lowk > 0 ? lowk / KVBLK : 0; }
#define ROWK(p, k0, rr) ((p) + (size_t)((k0) + (rr)) * LDK + sc)
#define ROWV(p, k0, rr) ((p) + (size_t)((k0) + (rr)) * LDV + sc)
#define VMW() asm volatile("s_waitcnt vmcnt(0)" ::: "memory")
#define VMWN(n) asm volatile("s_waitcnt vmcnt(%0)" :: "i"(n) : "memory")
#define SLOAD_H(Kp, Vp, k0) do { S.st_v0 = load8(ROWV(Vp, k0, sr)); S.st_v1 = load8(ROWV(Vp, k0, 32 + sr));              \
                         S.st_k0 = load8(ROWK(Kp, k0, sr)); S.st_k1 = load8(ROWK(Kp, k0, 32 + sr)); } while (0)
#define SWRITE_HK(bf) do { *(bf16x8*)(K_lds + (bf) * SHM_K + kws) = S.st_k0; *(bf16x8*)(K_lds + (bf) * SHM_K + kws + 32 * 256) = S.st_k1; } while (0)
#define SWRITE_HV(bf) do { *(bf16x8*)(V_lds + (bf) * SHM_V + vst0) = S.st_v0; *(bf16x8*)(V_lds + (bf) * SHM_V + vst1) = S.st_v1; } while (0)
#define SWRITE_H(bf) do { SWRITE_HV(bf); SWRITE_HK(bf); } while (0)
template <class TOut, int LDQ, int LDK, int LDV>
__device__ __forceinline__ void attn_prime(const BlockRef<TOut>& cur, int W, char* lds, Seam& S) {
    int tid_ = threadIdx.x; asm volatile("" : "+v"(tid_));
    const int tid = tid_, wid = __builtin_amdgcn_readfirstlane(tid >> 6), lane = tid & 63, r32 = lane & 31, hi = lane >> 5;
    const int sr = tid >> 4, sc = (tid & 15) * 8, kws = KSWZ(sr, sc * 2); char* K_lds = lds + 2 * SHM_V;
    const int kb0 = (swa_jlo(cur.P0, W) > cur.J0 ? swa_jlo(cur.P0, W) : cur.J0) * KVBLK;
    for (int d0 = 0; d0 < 8; ++d0) S.qr[d0] = load8(cur.Q + (size_t)(wid * QBLK + r32) * LDQ + d0 * 16 + hi * 8);
    SLOAD_H(cur.K, cur.V, kb0); VMW(); SWRITE_HK(0);
    __syncthreads();
}
template <int MODE, bool WSKIP, class TOut, int LDQ, int LDK, int LDV, int LDO>
__device__ __forceinline__ void attn_block(const BlockRef<TOut>& cur, const BlockRef<TOut>& nxt, int skv, int W, char* lds, Seam& S) {
    int tid_ = threadIdx.x; asm volatile("" : "+v"(tid_));
    const int tid = tid_, wid = __builtin_amdgcn_readfirstlane(tid >> 6), lane = tid & 63, r32 = lane & 31, hi = lane >> 5;
    const int j_lo = swa_jlo(cur.P0, W) > cur.J0 ? swa_jlo(cur.P0, W) : cur.J0;
    int j_hi = (cur.P0 + QB - 1) / KVBLK + 1; if (j_hi > skv / KVBLK) j_hi = skv / KVBLK;
    const int NT = j_hi - j_lo;
    const int kbn = (swa_jlo(nxt.P0, W) > nxt.J0 ? swa_jlo(nxt.P0, W) : nxt.J0) * KVBLK;
    const int qlo = cur.P0 + wid * QBLK, qm = qlo + r32 - 4 * hi;
    char* V_lds = lds; char* K_lds = lds + 2 * SHM_V;
    float* ws = (float*)(lds + 2 * SHM_V + 2 * SHM_K) + wid * 64; float* li_l = ws, * al_l = ws + 32;
    float m_reg = -1e30f, l_reg = 0; f32x16 o[4] = {};
    const int sr = tid >> 4, sc = (tid & 15) * 8, vst0 = v_st(sr, sc), vst1 = v_st(32 + sr, sc), kws = KSWZ(sr, sc * 2);
    const int vb0 = (int)(uintptr_t)V_lds + v_rd_base(lane);
    const bf16* Kh = cur.K; const bf16* Vh = cur.V;
    float cq = 0.f; const float* ckb = nullptr; unsigned selm = 0xffffffffu, wor = 0xffffffffu;
    if constexpr (MODE == 1) { const float* C = (const float*)cur.X; cq = C[qlo + r32]; ckb = C + 4 * hi; }
    if constexpr (MODE == 2) { const unsigned* SMp = (const unsigned*)cur.X; selm = SMp[qlo + r32]; wor = selm;
#pragma unroll
        for (int o_ = 1; o_ < 64; o_ <<= 1) wor |= (unsigned)__shfl_xor((int)wor, o_);
        wor = (unsigned)__builtin_amdgcn_readfirstlane((int)wor); }
#define RESC(a) do { if (__any((a) < 1.f)) { if (hi == 0) al_l[r32] = (a); asm volatile("s_waitcnt lgkmcnt(0)" ::: "memory");              \
                     for (int d_ = 0; d_ < 4; ++d_) for (int r = 0; r < 16; ++r) o[d_][r] *= al_l[crow(r, hi)]; } } while (0)
#define KBASE(t) ((j_lo + (t)) * KVBLK)
#define ACT(t) (KBASE(t) <= qlo + QBLK - 1 && KBASE(t) + KVBLK - 1 >= qlo - W + 1 && (MODE != 2 || ((wor >> (j_lo + (t))) & 1u)))
#define BIAST(P0_, P1_, t) do { if constexpr (MODE == 1) fox_bias(P0_, P1_, cq, ckb + KBASE(t)); } while (0)
#define MASKT(P0_, P1_, t) do { const int kb_ = KBASE(t); \
        if constexpr (MODE == 2) { if (!SK || ACT(t)) mask_tile(P0_, P1_, ((selm >> (j_lo + (t))) & 1u) ? qm - kb_ : -1000000, (unsigned)W); } \
        else { if ((!SK || ACT(t)) && (kb_ + KVBLK - 1 > qlo || kb_ <= qlo + QBLK - 1 - W)) mask_tile(P0_, P1_, qm - kb_, (unsigned)W); } } while (0)
    constexpr int NQL = 8;
    constexpr bool SK = WSKIP;
#define SEAM_K0() do { VMWN(NQL); SWRITE_HK(0); SBAR(); } while (0)
    f32x16 pA0, pA1, pB0, pB1; float mnA, mnB, alA, alB; bf16x8 pa0, pa1, pa2, pa3;
    SWRITE_HV(0); SBAR();
    if (NT > 1) { SLOAD_H(Kh, Vh, KBASE(1)); }
    SBAR(); qkt<0, SK>(pA0, pA1, K_lds, r32, hi, S.qr, ACT(0));
    BIAST(pA0, pA1, 0); MASKT(pA0, pA1, 0); partialSM(pA0, pA1, m_reg, mnA, alA);
    if (NT > 1) { VMW(); SWRITE_H(1); }
    __syncthreads();
#define HALF_STEP(PX0, PX1, mnX, alX, PY0, PY1, alY, t, KB, VB, SB) do {                                                      \
        SBAR(); qkt<KB, SK>(PX0, PX1, K_lds, r32, hi, S.qr, ACT(t));                                             \
        finishSM(PY0, PY1, alY, l_reg, pa0, pa1, pa2, pa3); SBAR();                                                           \
        if ((t) + 1 < NT) { SLOAD_H(Kh, Vh, KBASE((t) + 1)); SBAR(); }                                               \
        pv_tile<VB, SK>(o, vb0, pa0, pa1, pa2, pa3, ACT((t) - 1)); BIAST(PX0, PX1, (t)); MASKT(PX0, PX1, (t)); partialSM(PX0, PX1, m_reg, mnX, alX);                                        \
        __syncthreads();                                                                                                      \
        if ((t) + 1 < NT) { VMW(); SWRITE_H(SB); }                                                                          \
        RESC(alX); __syncthreads(); } while (0)
    for (int t = 1; t + 1 < NT; t += 2) {
        HALF_STEP(pB0, pB1, mnB, alB, pA0, pA1, alA, t, 1, 0, 0);
        HALF_STEP(pA0, pA1, mnA, alA, pB0, pB1, alB, t + 1, 0, 1, 1);
    }
    const bool even = (NT & 1) == 0;
    if (even) { SBAR(); qkt<1, SK>(pB0, pB1, K_lds, r32, hi, S.qr, ACT(NT - 1)); SBAR(); }
    { SLOAD_H(nxt.K, nxt.V, kbn); SBAR();
#pragma unroll
        for (int d0 = 0; d0 < 8; ++d0) S.qr[d0] = load8(nxt.Q + (size_t)(wid * QBLK + r32) * LDQ + d0 * 16 + hi * 8); }
    SBAR();
    finishSM(pA0, pA1, alA, l_reg, pa0, pa1, pa2, pa3); SBAR();
    pv_tile<0, SK>(o, vb0, pa0, pa1, pa2, pa3, ACT(even ? NT - 2 : NT - 1));
    if (even) { BIAST(pB0, pB1, NT - 1); MASKT(pB0, pB1, NT - 1); partialSM(pB0, pB1, m_reg, mnB, alB); __syncthreads(); RESC(alB);
        finishSM(pB0, pB1, alB, l_reg, pa0, pa1, pa2, pa3); SBAR(); pv_tile<1, SK>(o, vb0, pa0, pa1, pa2, pa3, ACT(NT - 1)); }
    SBAR(); SEAM_K0();
    if (hi == 0) li_l[r32] = l_reg; asm volatile("s_waitcnt lgkmcnt(0)" ::: "memory");
    float rli[16];
#pragma unroll
    for (int r = 0; r < 16; ++r) rli[r] = __builtin_amdgcn_rcpf(li_l[crow(r, hi)]);
    TOut* Ow = cur.O + (size_t)(wid * QBLK) * LDO;
    float addv[4][16];
    if constexpr (MODE == 2) { const unsigned short* Yp = (const unsigned short*)cur.Y + (size_t)(wid * QBLK) * LDO; const float* Zp = (const float*)cur.Z + (size_t)(wid * QBLK) * 96;
#pragma unroll
        for (int r = 0; r < 16; ++r) { const int orow = crow(r, hi); rli[r] *= Zp[orow * 96];
#pragma unroll
            for (int d0 = 0; d0 < 4; ++d0) addv[d0][r] = __uint_as_float((unsigned)Yp[(size_t)orow * LDO + d0 * 32 + r32] << 16); } }
#pragma unroll
    for (int r = 0; r < 16; ++r) { const int orow = crow(r, hi);
#pragma unroll
        for (int d0 = 0; d0 < 4; ++d0) { float v = o[d0][r] * rli[r]; if constexpr (MODE == 2) v += addv[d0][r];
            if constexpr (same_t<TOut, float>::v) { Ow[(size_t)orow * LDO + d0 * 32 + r32] = v; }
            else { const float vn = __shfl_xor(v, 1);
                   if ((r32 & 1) == 0) *(unsigned*)(Ow + (size_t)orow * LDO + d0 * 32 + r32) = cvtpk(v, vn); } } }
    __syncthreads();
#undef RESC
#undef KBASE
#undef ACT
#undef BIAST
#undef MASKT
#undef SEAM_K0
#undef HALF_STEP
}

__host__ __device__ inline int swa_nramp(int nqb, int W, int qoff) { const int t = W - 1 - qoff; const int n = t < 0 ? 0 : t / QB + 1; return n > nqb ? nqb : n; }
__host__ __device__ inline int swa_nx(int nqb, int nramp) { return (nramp + 1) / 2 + (nqb - nramp); }
struct SwaItem { int bh, qb0, qb1; };
__device__ __forceinline__ SwaItem swa_decode(int L, int nqb, int nx, int nramp) {
    SwaItem it; it.bh = L / nx; const int x = L - it.bh * nx; const int ns = nqb - nramp;
    if (x < ns) { it.qb0 = it.qb1 = nqb - 1 - x; } else { it.qb0 = x - ns; it.qb1 = nramp - 1 - it.qb0; }
    return it;
}
template <int MODE, bool WSKIP, class TOut, int LDQ, int LDK, int LDV, int LDO, class Mk>
__device__ __forceinline__ void attn_stream(char* lds, int skv, int W, int nheads, int G, int c, const Mk& mk) {
    const int nqb = skv / QB, nramp = swa_nramp(nqb, W, 0), nx = swa_nx(nqb, nramp), total = nx * nheads;
    int L = c; if (L >= total) return;
    SwaItem it = swa_decode(L, nqb, nx, nramp); int pass = 0;
    BlockRef<TOut> cur = mk(it.bh, it.qb0);
    Seam S;
    attn_prime<TOut, LDQ, LDK, LDV>(cur, W, lds, S);
    for (;;) {
        const bool more_pass = pass == 0 && it.qb1 != it.qb0, more_item = L + G < total, last = !more_pass && !more_item;
        SwaItem itn = it; int passn = pass + 1, Ln = L;
        if (!more_pass) { passn = 0; Ln = more_item ? L + G : L; itn = swa_decode(Ln, nqb, nx, nramp); }
        const BlockRef<TOut> nxt = last ? cur : mk(itn.bh, passn ? itn.qb1 : itn.qb0);
        attn_block<MODE, WSKIP, TOut, LDQ, LDK, LDV, LDO>(cur, nxt, skv, W, lds, S);
        if (last) break;
        cur = nxt; it = itn; pass = passn; L = Ln;
    }
}
#undef ROWK
#undef ROWV
#undef SLOAD_H
#undef SWRITE_HK
#undef SWRITE_HV
#undef SWRITE_H
}

constexpr int NWAVES = 8;
constexpr int BATCH = 4, T = 2048, M = BATCH * T, D = 4096, FF = 11008;
constexpr int NP0 = 12544, NP1 = 7424;
constexpr int N_IN0 = 12304, N_IN1 = 7264;
constexpr int E_FQ = 0, E_FK = 2048, E_FV = 4096, E_DQ = 6144, E_DK = 8192, E_DV = 10240, E_FG = 12288;
constexpr int O_Q = 0, O_KC = 4096, O_VC = 4608, O_KS = 5120, O_VS = 5632, O_KW = 6144, O_VW = 6656, O_GT = 7168;
constexpr int NCMP = 127, WINDOW = 512;
constexpr float RMS_EPS = 1e-6f;
constexpr int CAUSAL_W = 1 << 30;

typedef unsigned short bf16;
typedef unsigned v4u __attribute__((ext_vector_type(4)));
typedef unsigned v2u __attribute__((ext_vector_type(2)));
typedef float f32x4 __attribute__((ext_vector_type(4)));
typedef float f32x2 __attribute__((ext_vector_type(2)));
#define LDS_WAIT() asm volatile("s_waitcnt lgkmcnt(0)" ::: "memory")

constexpr size_t MiB = 1u << 20;
constexpr size_t WS_CTL = 0, CTL_ZERO_BYTES = 1 * MiB;
constexpr size_t SZ_WGU = (size_t)2 * FF * D * 2, SZ_WD = (size_t)D * FF * 2, SZ_WIN0 = (size_t)NP0 * D * 2, SZ_WIN1 = (size_t)NP1 * D * 2, SZ_WOUT = (size_t)D * D * 2;
constexpr size_t WS_WGU = 1 * MiB;
constexpr size_t WS_WD = WS_WGU + 4 * SZ_WGU;
constexpr size_t WS_WIN0 = WS_WD + 4 * SZ_WD;
constexpr size_t WS_WOUT0 = WS_WIN0 + SZ_WIN0;
constexpr size_t WS_WIN1 = WS_WOUT0 + SZ_WOUT;
constexpr size_t WS_WOUT1 = WS_WIN1 + SZ_WIN1;
constexpr size_t WS_W1C = WS_WOUT1 + SZ_WOUT;
constexpr size_t WS_XN = WS_W1C + (size_t)512 * 4096 * 2;
constexpr size_t WS_MIX = WS_XN + (size_t)M * D * 2;
constexpr size_t WS_QROT = WS_MIX + (size_t)M * D * 2;
constexpr size_t WS_PROJ = WS_QROT + (size_t)M * D * 2;
constexpr size_t WS_SCR = WS_PROJ + (size_t)M * NP0 * 2;
constexpr size_t SZ_SCR = (size_t)3 * M * D * 4;
constexpr size_t WS_TAB = WS_SCR + SZ_SCR;
constexpr size_t WS_FG = WS_TAB + (size_t)T * 64 * 8;
constexpr size_t WS_CUM = WS_FG + (size_t)M * 16 * 4;
constexpr size_t WS_GATES = WS_CUM + (size_t)64 * T * 4;
constexpr size_t WS_ACMP = WS_GATES + (size_t)M * 96 * 4;
constexpr size_t WS_HIDC = WS_ACMP + (size_t)4096 * 4096 * 2;
constexpr size_t WS_KVC = WS_HIDC + (size_t)4096 * 256 * 2;
constexpr size_t WS_SELM = WS_KVC + (size_t)2 * 2048 * 128 * 2;
constexpr size_t WS_CBP = WS_SELM + (size_t)16 * T * 4;
constexpr size_t WS_CB = WS_CBP + (size_t)32 * 512 * 4;
constexpr size_t WS_DUMP = WS_CB + 4096;
constexpr size_t WS_NMAX = WS_DUMP + 16384;
constexpr size_t WS_PART = WS_NMAX + 4096;
constexpr size_t WS_H = WS_PART + (size_t)M * 64 * 4;
constexpr size_t WS_END = WS_H + (size_t)M * D * 2;
constexpr int CW_BAR = 4096;

constexpr int RING_BYTES = 131072;
constexpr int MISC_OFF = RING_BYTES + 320;
constexpr int RS_OFF = RING_BYTES + 1024;
constexpr int LDS_BYTES = 147456;

__device__ __forceinline__ unsigned f2bf(float f) { unsigned u = __builtin_bit_cast(unsigned, f); return (u + 0x7fffu + ((u >> 16) & 1u)) >> 16; }
__device__ __forceinline__ unsigned pk2(float lo, float hi) { return f2bf(lo) | (f2bf(hi) << 16); }
__device__ __forceinline__ float bf_lo(unsigned w) { return __builtin_bit_cast(float, w << 16); }
__device__ __forceinline__ float bf_hi(unsigned w) { return __builtin_bit_cast(float, w & 0xffff0000u); }
__device__ __forceinline__ float wave_sum(float v) {
#pragma unroll
    for (int o = 1; o < 64; o <<= 1) v += __shfl_xor(v, o);
    return v;
}

struct Args { const float* in[29]; float* out; unsigned char* ws; int ph_lo, ph_hi; };
struct Ctx {
    int tid, lane, wave, G, bid, gw, NGW;
    unsigned char* ws;
    float* out;
};

__device__ __forceinline__ int rowmap(int mode, int off, int n) {
    if (mode == 1) return ((n >> 7) << 8) + (n & 127) + off;
    if (mode == 2) return n < 6144 ? n : (n < 6160 ? E_FG + (n - 6144) : n - 16);
    return n + off;
}
struct Pend { f32x4 v[2][8]; float gk[2][8]; bf16* d; int K; };
__device__ __forceinline__ void tr_issue(Pend& p, const float* W, int K, int N, bf16* WT, int mode, int off, int item, int lane, bool tiled, bf16* dump, const float* gain, bool has_gain) {
    const int nblk = (N + 63) / 64, kb = item / nblk, nb = item - kb * nblk, k0 = 64 * kb, cq = lane & 15, rq = lane >> 4, n = 64 * nb + 4 * cq;
    const bool ok = n < N; const int nc = ok ? n : N - 4;
    bf16* d = tiled ? WT + ((size_t)kb * N + rowmap(mode, off, nc)) * 64 + 8 * rq : WT + (size_t)rowmap(mode, off, nc) * K + k0 + 8 * rq;
    p.d = ok ? d : dump + lane * 128; p.K = ok ? (tiled ? 64 : K) : 0;
    const float* src = W + (size_t)(k0 + 8 * rq) * N + nc;
#pragma unroll
    for (int j = 0; j < 2; ++j)
#pragma unroll
        for (int i = 0; i < 8; ++i) { p.v[j][i] = *(const f32x4*)(src + (size_t)(32 * j + i) * N); const float g = gain[has_gain ? k0 + 8 * rq + 32 * j + i : 0]; p.gk[j][i] = has_gain ? g : 1.0f; }
}
__device__ __forceinline__ void tr_flush(Pend& p) {
#pragma unroll
    for (int e = 0; e < 4; ++e) { bf16* drow = p.d + (size_t)e * p.K;
#pragma unroll
        for (int j = 0; j < 2; ++j) { v4u o; o.x = pk2(p.v[j][0][e] * p.gk[j][0], p.v[j][1][e] * p.gk[j][1]); o.y = pk2(p.v[j][2][e] * p.gk[j][2], p.v[j][3][e] * p.gk[j][3]); o.z = pk2(p.v[j][4][e] * p.gk[j][4], p.v[j][5][e] * p.gk[j][5]); o.w = pk2(p.v[j][6][e] * p.gk[j][6], p.v[j][7][e] * p.gk[j][7]);
            *(v4u*)(drow + 32 * j) = o; } }
}
__device__ __forceinline__ void rms_row_bf16(const float* xrow, const float* gain, bf16* orow, int lane) {
    const f32x4* xr = (const f32x4*)xrow + lane; const f32x4* gr = (const f32x4*)gain + lane;
    f32x4 v[16]; float s = 0.f;
#pragma unroll
    for (int j = 0; j < 16; ++j) { v[j] = xr[64 * j]; s += (v[j].x * v[j].x + v[j].y * v[j].y) + (v[j].z * v[j].z + v[j].w * v[j].w); }
    const float r = 1.0f / sqrtf(wave_sum(s) * (1.0f / D) + RMS_EPS);
    v2u* o8 = (v2u*)orow + lane;
#pragma unroll
    for (int j = 0; j < 16; ++j) { const f32x4 g = gr[64 * j]; v2u w; w.x = pk2(v[j].x * r * g.x, v[j].y * r * g.y); w.y = pk2(v[j].z * r * g.z, v[j].w * r * g.w); o8[64 * j] = w; }
}
__device__ __forceinline__ void norm_phase(const Ctx& C, const float* src, const float* gain, bf16* dst) {
    for (int m = C.gw; m < M; m += C.NGW) rms_row_bf16(src + (size_t)m * D, gain, dst + (size_t)m * D, C.lane);
}
__device__ __forceinline__ float load_hrow(const bf16* hrow, int lane, f32x4 (&v)[8][2]) {
    const v4u* hr = (const v4u*)hrow + lane; float s = 0.f;
#pragma unroll
    for (int j = 0; j < 8; ++j) { const v4u w = hr[64 * j];
        v[j][0] = (f32x4){bf_lo(w.x), bf_hi(w.x), bf_lo(w.y), bf_hi(w.y)}; v[j][1] = (f32x4){bf_lo(w.z), bf_hi(w.z), bf_lo(w.w), bf_hi(w.w)};
#pragma unroll
        for (int q = 0; q < 2; ++q) s += (v[j][q].x * v[j][q].x + v[j][q].y * v[j][q].y) + (v[j][q].z * v[j][q].z + v[j][q].w * v[j][q].w); }
    return 1.0f / sqrtf(wave_sum(s) * (1.0f / D) + RMS_EPS);
}
__device__ __forceinline__ void norm_phase_h(const Ctx& C, const bf16* h, const float* gain, bf16* dst) {
    for (int m = C.gw; m < M; m += C.NGW) { f32x4 v[8][2]; const float r = load_hrow(h + (size_t)m * D, C.lane, v);
        const f32x4* gr = (const f32x4*)gain + 2 * C.lane; v4u* o = (v4u*)(dst + (size_t)m * D) + C.lane;
#pragma unroll
        for (int j = 0; j < 8; ++j) { const f32x4 g0 = gr[128 * j], g1 = gr[128 * j + 1]; v4u w;
            w.x = pk2(v[j][0].x * r * g0.x, v[j][0].y * r * g0.y); w.y = pk2(v[j][0].z * r * g0.z, v[j][0].w * r * g0.w);
            w.z = pk2(v[j][1].x * r * g1.x, v[j][1].y * r * g1.y); w.w = pk2(v[j][1].z * r * g1.z, v[j][1].w * r * g1.w); o[64 * j] = w; } }
}
__device__ __forceinline__ void final_norm_phase(const Ctx& C, const bf16* h, const float* gain, float* out) {
    for (int m = C.gw; m < M; m += C.NGW) { f32x4 v[8][2]; const float r = load_hrow(h + (size_t)m * D, C.lane, v);
        const f32x4* gr = (const f32x4*)gain + 2 * C.lane; f32x4* o = (f32x4*)(out + (size_t)m * D) + 2 * C.lane;
#pragma unroll
        for (int j = 0; j < 8; ++j) { const f32x4 g0 = gr[128 * j], g1 = gr[128 * j + 1];
            o[128 * j] = (f32x4){v[j][0].x * r * g0.x, v[j][0].y * r * g0.y, v[j][0].z * r * g0.z, v[j][0].w * r * g0.w};
            o[128 * j + 1] = (f32x4){v[j][1].x * r * g1.x, v[j][1].y * r * g1.y, v[j][1].z * r * g1.z, v[j][1].w * r * g1.w}; } }
}

__device__ __forceinline__ void prep_rstd(const float* part, int pm, LAS float* rs, int tid) {
    const int row = tid >> 1, half = tid & 1;
    const f32x4* p = (const f32x4*)(part + ((size_t)pm * 256 + row) * 64 + half * 32);
    f32x4 a = p[0];
#pragma unroll
    for (int i = 1; i < 8; ++i) a += p[i];
    float s = (a[0] + a[1]) + (a[2] + a[3]); s += __shfl_xor(s, 1);
    if (half == 0) rs[row] = 1.0f / sqrtf(s * (1.0f / D) + RMS_EPS);
    __syncthreads();
}
constexpr int CI_F = 11008, CI_F3 = 3 * CI_F, CI_W0 = 64 * 193, CI_WO = 64 * 64, CI_W1 = 64 * 114, CI_C = 64 * 4;
constexpr int CB_F0 = 0, CB_W0 = CB_F0 + CI_F3, CB_WO0 = CB_W0 + CI_W0, CB_F1 = CB_WO0 + CI_WO, CB_F2 = CB_F1 + CI_F3, CB_W1 = CB_F2 + CI_F3, CB_C = CB_W1 + CI_W1,
              CB_WO1 = CB_C + 2 * CI_C, CB_F3 = CB_WO1 + CI_WO, CB_END = CB_F3 + CI_F3;
__device__ __forceinline__ void conv_issue(Pend& p, const Args& A, unsigned char* ws, int g, int lane) {
    const float* src; bf16* dst; int K = D, N = D, mode = 0, off = 0, r = g, f = -1; bool tiled = false; const float* gain = A.in[1]; bool has_gain = false;
    if (g < CB_W0) { f = 0; }
    else if (g < CB_WO0) { r = g - CB_W0; src = A.in[10]; dst = (bf16*)(ws + WS_WIN0); N = N_IN0; mode = 2; gain = A.in[5]; has_gain = true; }
    else if (g < CB_F1) { r = g - CB_WO0; src = A.in[17]; dst = (bf16*)(ws + WS_WOUT0); }
    else if (g < CB_F2) { f = 1; r = g - CB_F1; }
    else if (g < CB_W1) { f = 2; r = g - CB_F2; }
    else if (g < CB_C) { r = g - CB_W1; src = A.in[18]; dst = (bf16*)(ws + WS_WIN1); N = N_IN1; gain = A.in[5] + D; has_gain = true; }
    else if (g < CB_WO1) { r = g - CB_C; N = 256; dst = (bf16*)(ws + WS_W1C); if (r < CI_C) { src = A.in[20]; } else { r -= CI_C; src = A.in[24]; off = 256; } }
    else if (g < CB_F3) { r = g - CB_WO1; src = A.in[27]; dst = (bf16*)(ws + WS_WOUT1); }
    else { f = 3; r = g - CB_F3; }
    if (f >= 0) { const int which = r / CI_F, layer = f >> 1, half = f & 1; r -= which * CI_F;
        if (which < 2) { src = (half ? (which ? A.in[8] : A.in[7]) : (which ? A.in[3] : A.in[2])) + (size_t)layer * D * FF; dst = (bf16*)(ws + WS_WGU + (size_t)f * SZ_WGU); N = FF; mode = 1; off = which * 128; gain = (half ? A.in[6] : A.in[1]) + (size_t)layer * D; has_gain = true; }
        else { src = (half ? A.in[9] : A.in[4]) + (size_t)layer * FF * D; dst = (bf16*)(ws + WS_WD + (size_t)f * SZ_WD); K = FF; tiled = true; } }
    tr_issue(p, src, K, N, dst, mode, off, r, lane, tiled, (bf16*)(ws + WS_DUMP), gain, has_gain);
}
__device__ __forceinline__ void convert_range(const Args& A, unsigned char* ws, int lo, int hi, int wi, int nw, int lane) {
    const int g0 = lo + wi;
    if (g0 >= hi) return;
    Pend P0, P1;
    conv_issue(P0, A, ws, g0, lane);
    for (int g = g0; g < hi; g += 2 * nw) {
        const int g1 = g + nw < hi ? g + nw : hi - 1, g2 = g + 2 * nw < hi ? g + 2 * nw : hi - 1;
        conv_issue(P1, A, ws, g1, lane);
        tr_flush(P0);
        conv_issue(P0, A, ws, g2, lane);
        tr_flush(P1);
    }
}
#ifndef TCAP_GU
#define TCAP_GU 6500
#endif
#ifndef TCAP_W0
#define TCAP_W0 19000
#endif
#ifndef TCAP_W1
#define TCAP_W1 9500
#endif
#ifndef TCAP_CMP
#define TCAP_CMP 18000
#endif
constexpr int T1_LO = CB_W0, T1_HI = T1_LO + TCAP_GU;
constexpr int T4_LO = CB_F1, T4_HI = T4_LO + TCAP_W0;
constexpr int T10_LO = CB_F2, T10_HI = T10_LO + TCAP_GU;
constexpr int T13_LO = CB_W1, T13_HI = T13_LO + TCAP_GU;
constexpr int T16_LO = CB_F3, T16_HI = T16_LO + TCAP_W1;
constexpr int T25_LO = CB_END - TCAP_GU, T25_HI = CB_END;
static_assert(T1_HI <= CB_WO0 && T4_HI <= CB_F2 && T10_HI <= CB_W1 && T13_HI <= CB_C && T16_HI <= T25_LO && T25_LO >= CB_F3 + 2 * CI_F, "tail ranges");
__device__ __forceinline__ void prologue_phase(const Args& A, const Ctx& C, LAS unsigned char* lds) {
    convert_range(A, C.ws, CB_F0, T1_LO, C.gw, C.NGW, C.lane);
    convert_range(A, C.ws, T1_HI, CB_WO0, C.gw, C.NGW, C.lane);
    { const int gt = C.bid * 512 + C.tid, NGT = C.G * 512; const v4u z = {0u, 0u, 0u, 0u};
        v4u* p0 = (v4u*)(C.ws + WS_WIN0 + (size_t)N_IN0 * D * 2); const int n0 = (NP0 - N_IN0) * D * 2 / 16;
        for (int i = gt; i < n0; i += NGT) p0[i] = z;
        v4u* p1 = (v4u*)(C.ws + WS_WIN1 + (size_t)N_IN1 * D * 2); const int n1 = (NP1 - N_IN1) * D * 2 / 16;
        for (int i = gt; i < n1; i += NGT) p1[i] = z;
        f32x2* tab = (f32x2*)(C.ws + WS_TAB);
        for (int i = gt; i < T * 64; i += NGT) { const int t = i >> 6, k = i & 63;
            const float inv = powf(10000.0f, -(float)k / 64.0f); const float ang = (float)t * inv;
            tab[i] = (f32x2){(float)cos((double)ang), (float)sin((double)ang)}; }
    }
    { float* cbp = (float*)(C.ws + WS_CBP);
        if (C.wave == 0) for (int u = C.bid; u < 256; u += C.G) { const int mat = u >> 7, jb = (u >> 5) & 3, kc = u & 31;
            const float* pe = mat ? A.in[23] : A.in[19]; const float* w1 = mat ? A.in[24] : A.in[20]; const int j = jb * 64 + C.lane;
            float s = 0.f;
            for (int k = kc * 128; k < kc * 128 + 128; ++k) s += pe[k] * w1[(size_t)k * 256 + j];
            cbp[kc * 512 + mat * 256 + j] = s; } }
    { float* part = (float*)(C.ws + WS_PART); bf16* XNp = (bf16*)(C.ws + WS_XN);
        for (int m = C.gw; m < M; m += C.NGW) { const f32x4* xr = (const f32x4*)(A.in[0] + (size_t)m * D) + C.lane; v2u* o8 = (v2u*)(XNp + (size_t)m * D) + C.lane; float ss = 0.f;
#pragma unroll
            for (int j = 0; j < 16; ++j) { const f32x4 v = xr[64 * j]; v2u w; w.x = pk2(v.x, v.y); w.y = pk2(v.z, v.w); o8[64 * j] = w;
                ss += (bf_lo(w.x) * bf_lo(w.x) + bf_hi(w.x) * bf_hi(w.x)) + (bf_lo(w.y) * bf_lo(w.y) + bf_hi(w.y) * bf_hi(w.y)); }
            ss = wave_sum(ss); part[(size_t)m * 64 + C.lane] = C.lane == 0 ? ss : 0.f; } }
}

__device__ __forceinline__ void rope_heads(const bf16* src, bf16* dst, int nh, const f32x2* tabrow, int lane) {
    const int i0 = 8 * (lane & 7); const f32x4* tp = (const f32x4*)(tabrow + i0);
    const f32x4 t0 = tp[0], t1 = tp[1], t2 = tp[2], t3 = tp[3];
    for (int h = (lane >> 3); h < nh; h += 8) {
        const v4u a = *(const v4u*)(src + h * 128 + i0), b = *(const v4u*)(src + h * 128 + 64 + i0);
        v4u o1, o2;
#define ROPE2(AW, BW, T, O1, O2) do { const float x1l = bf_lo(AW), x1h = bf_hi(AW), x2l = bf_lo(BW), x2h = bf_hi(BW); \
            O1 = pk2(x1l * T.x - x2l * T.y, x1h * T.z - x2h * T.w); O2 = pk2(x2l * T.x + x1l * T.y, x2h * T.z + x1h * T.w); } while (0)
        ROPE2(a.x, b.x, t0, o1.x, o2.x); ROPE2(a.y, b.y, t1, o1.y, o2.y); ROPE2(a.z, b.z, t2, o1.z, o2.z); ROPE2(a.w, b.w, t3, o1.w, o2.w);
#undef ROPE2
        *(v4u*)(dst + h * 128 + i0) = o1; *(v4u*)(dst + h * 128 + 64 + i0) = o2;
    }
}
__device__ __forceinline__ void even_post_phase(const Args& A, const Ctx& C) {
    bf16* proj = (bf16*)(C.ws + WS_PROJ); const f32x2* tab = (const f32x2*)(C.ws + WS_TAB);
    for (int tok = C.gw; tok < M; tok += C.NGW) { bf16* p = proj + (size_t)tok * NP0 + E_DQ; rope_heads(p, p, 32, tab + (tok & (T - 1)) * 64, C.lane); }
    const float* fg = (const float*)(C.ws + WS_FG); float* cum = (float*)(C.ws + WS_CUM); const float* bfg = A.in[11];
    { float* nmax = (float*)(C.ws + WS_NMAX); const int sub = C.lane & 15, rr = C.lane >> 4;
        for (int task = C.gw; task < 1024; task += C.NGW) { const int which = task & 1, blk = (task >> 1) & 7, bh = task >> 4, b = bh >> 4, h = bh & 15;
            const bf16* p = proj + (size_t)(b * T + blk * 256 + rr) * NP0 + (which ? E_FK : E_FQ) + h * 128 + 8 * sub; float mx = 0.f;
#pragma unroll 8
            for (int it = 0; it < 64; ++it) { const v4u w = *(const v4u*)(p + (size_t)(4 * it) * NP0);
                float ss = (bf_lo(w.x) * bf_lo(w.x) + bf_hi(w.x) * bf_hi(w.x)) + (bf_lo(w.y) * bf_lo(w.y) + bf_hi(w.y) * bf_hi(w.y)) + (bf_lo(w.z) * bf_lo(w.z) + bf_hi(w.z) * bf_hi(w.z)) + (bf_lo(w.w) * bf_lo(w.w) + bf_hi(w.w) * bf_hi(w.w));
                ss += __shfl_xor(ss, 1); ss += __shfl_xor(ss, 2); ss += __shfl_xor(ss, 4); ss += __shfl_xor(ss, 8);
                mx = fmaxf(mx, ss); }
            mx = fmaxf(mx, __shfl_xor(mx, 16)); mx = fmaxf(mx, __shfl_xor(mx, 32));
            if (C.lane == 0) nmax[which * 512 + bh * 8 + blk] = mx; } }
    for (int task = C.gw; task < 64 * (T / 64); task += C.NGW) { const int s = task >> 5, c = task & 31, b = s >> 4, h = s & 15; const float bias = bfg[h];
        double acc = 0.0;
        for (int cc = 0; cc < c; ++cc) { const float x = fg[(size_t)(b * T + cc * 64 + C.lane) * 16 + h] + bias; acc += (double)(fminf(x, 0.f) - log1pf(expf(-fabsf(x)))); }
#pragma unroll
        for (int o = 1; o < 64; o <<= 1) acc += __shfl_xor(acc, o);
        const int t = c * 64 + C.lane;
        const float x = fg[(size_t)(b * T + t) * 16 + h] + bias;
        double v = (double)(fminf(x, 0.f) - log1pf(expf(-fabsf(x))));
#pragma unroll
        for (int o = 1; o < 64; o <<= 1) { const double u = __shfl_up(v, o); if (C.lane >= o) v += u; }
        cum[(size_t)s * T + t] = (float)(v + acc); }
}
__device__ __forceinline__ void even_combine_phase(const Args& A, const Ctx& C) {
    const bf16* O1 = (const bf16*)(C.ws + WS_SCR); const bf16* O2 = O1 + (size_t)M * 2048; bf16* mix = (bf16*)(C.ws + WS_MIX);
    float s1 = A.in[12][C.lane] * A.in[13][C.lane] + A.in[12][C.lane + 64] * A.in[13][C.lane + 64];
    float s2 = A.in[14][C.lane] * A.in[15][C.lane] + A.in[14][C.lane + 64] * A.in[15][C.lane + 64];
    const float lam_init = 0.2f;
    const float lam = expf(wave_sum(s1)) - expf(wave_sum(s2)) + lam_init;
    const f32x4 sg = ((const f32x4*)A.in[16])[C.lane];
    for (int tok = C.gw; tok < M; tok += C.NGW) {
        const v2u* a1 = (const v2u*)(O1 + (size_t)tok * 2048) + C.lane; const v2u* a2 = (const v2u*)(O2 + (size_t)tok * 2048) + C.lane;
        v2u* o = (v2u*)(mix + (size_t)tok * D + 2048) + C.lane;
#pragma unroll
        for (int h = 0; h < 8; ++h) { const v2u p1 = a1[64 * h], p2 = a2[64 * h];
            const f32x4 x = (f32x4){bf_lo(p1.x), bf_hi(p1.x), bf_lo(p1.y), bf_hi(p1.y)} - (f32x4){bf_lo(p2.x), bf_hi(p2.x), bf_lo(p2.y), bf_hi(p2.y)} * lam;
            const float ss = wave_sum((x.x * x.x + x.y * x.y) + (x.z * x.z + x.w * x.w));
            const float r = 1.0f / sqrtf(ss * (1.0f / 256.0f) + RMS_EPS);
            v2u w; w.x = pk2(x.x * r * sg.x * (1.0f - lam_init), x.y * r * sg.y * (1.0f - lam_init)); w.y = pk2(x.z * r * sg.z * (1.0f - lam_init), x.w * r * sg.w * (1.0f - lam_init));
            o[64 * h] = w; }
    }
}
__device__ __forceinline__ void odd_post_phase(const Args& A, const Ctx& C) {
    bf16* proj = (bf16*)(C.ws + WS_PROJ); bf16* qrot = (bf16*)(C.ws + WS_QROT); const f32x2* tab = (const f32x2*)(C.ws + WS_TAB);
    for (int tok = C.gw; tok < M; tok += C.NGW) { bf16* p = proj + (size_t)tok * NP1; const f32x2* tr = tab + (tok & (T - 1)) * 64;
        rope_heads(p + O_Q, qrot + (size_t)tok * D, 32, tr, C.lane);
        rope_heads(p + O_KS, p + O_KS, 4, tr, C.lane);
        rope_heads(p + O_KW, p + O_KW, 4, tr, C.lane); }
    bf16* AC = (bf16*)(C.ws + WS_ACMP);
    for (int u = C.gw; u < 4096; u += C.NGW) { const int mat = u >> 11, r = u & 2047; v4u* dst = (v4u*)(AC + (size_t)u * 4096) + C.lane;
        if (r < 2032) { const int g = r & 3, bn = r >> 2, b = bn / NCMP, n = bn - b * NCMP;
            const bf16* src = proj + (size_t)(b * T + 16 * n + (C.lane >> 4)) * NP1 + (mat ? O_VC : O_KC) + g * 128 + 8 * (C.lane & 15);
#pragma unroll
            for (int l = 0; l < 8; ++l) dst[l * 64] = *(const v4u*)(src + (size_t)(4 * l) * NP1); }
        else { const v4u z = {0u, 0u, 0u, 0u};
#pragma unroll
            for (int l = 0; l < 8; ++l) dst[l * 64] = z; } }
    if (C.bid == 0) { const float* cbp = (const float*)(C.ws + WS_CBP); float* cb = (float*)(C.ws + WS_CB); const int j = C.tid;
        float s = (j < 256 ? A.in[21] : A.in[25])[j & 255];
        for (int kc = 0; kc < 32; ++kc) s += cbp[kc * 512 + j];
        cb[j] = s; }
}
__device__ __forceinline__ void cmp2_phase(const Args& A, const Ctx& C) {
    const bf16* hid = (const bf16*)(C.ws + WS_HIDC); bf16* kvc = (bf16*)(C.ws + WS_KVC);
    const int gt = C.bid * 512 + C.tid, NGT = C.G * 512;
    for (int o = gt; o < 2 * 2048 * 128; o += NGT) { const int d = o & 127, r = (o >> 7) & 2047, mat = o >> 18;
        float s = 0.f;
        if (r < 2032) { const float* w2 = (mat ? A.in[26] : A.in[22]) + d; const unsigned* hr = (const unsigned*)(hid + (size_t)(mat * 2048 + r) * 256);
#pragma unroll 8
            for (int j = 0; j < 128; ++j) { const unsigned w = hr[j]; s += bf_lo(w) * w2[(size_t)(2 * j) * 128]; s += bf_hi(w) * w2[(size_t)(2 * j + 1) * 128]; } }
        kvc[o] = (bf16)f2bf(s); }
}
__device__ __forceinline__ void odd_combine_phase(const Ctx& C) {
    const bf16* oc = (const bf16*)(C.ws + WS_SCR); const bf16* os = oc + (size_t)M * D; const bf16* ow = os + (size_t)M * D;
    const float* gates = (const float*)(C.ws + WS_GATES); bf16* mix = (bf16*)(C.ws + WS_MIX);
    for (int tok = C.gw; tok < M; tok += C.NGW) { const size_t ro = (size_t)tok * D;
#pragma unroll 4
        for (int j = 0; j < 16; ++j) { const int col = 4 * (C.lane + 64 * j), head = col >> 7; const float* gp = gates + (size_t)tok * 96 + head * 3;
            const float g0 = gp[0], g1 = gp[1], g2 = gp[2];
            const v2u pa = *(const v2u*)(oc + ro + col), pb = *(const v2u*)(os + ro + col), pc = *(const v2u*)(ow + ro + col);
            const f32x4 a = {bf_lo(pa.x), bf_hi(pa.x), bf_lo(pa.y), bf_hi(pa.y)}, b = {bf_lo(pb.x), bf_hi(pb.x), bf_lo(pb.y), bf_hi(pb.y)}, c = {bf_lo(pc.x), bf_hi(pc.x), bf_lo(pc.y), bf_hi(pc.y)};
            const f32x4 r = a * g0 + b * g1 + c * g2; v2u w; w.x = pk2(r.x, r.y); w.y = pk2(r.z, r.w); *(v2u*)(mix + ro + col) = w; } }
}

__device__ __forceinline__ void cmp_attn_phase(const Ctx& C, char* lds) {
    using namespace att;
    const int tid = C.tid, wid = C.wave, lane = C.lane, r32 = lane & 31, hi = lane >> 5;
    char* V_lds = lds; char* K_lds = lds + 2 * SHM_V;
    float* impw = (float*)(lds + 65536);
    float* imps = impw + 8 * 32 * 33;
    const att::bf16* proj = (const att::bf16*)(C.ws + WS_PROJ);
    const att::bf16* kc = (const att::bf16*)(C.ws + WS_KVC); const att::bf16* vc = kc + 2048 * 128;
    att::bf16* ocmp = (att::bf16*)(C.ws + WS_SCR); unsigned* selm = (unsigned*)(C.ws + WS_SELM);
    const unsigned short* owin = (const unsigned short*)(C.ws + WS_SCR) + (size_t)2 * M * D; const float* gates = (const float*)(C.ws + WS_GATES);
    const int vb0 = (int)(uintptr_t)V_lds + v_rd_base(lane);
    for (int u = C.bid; u < 256; u += C.G) {
        const int bg = u >> 4, b = bg >> 2, g = bg & 3, tt0 = (u & 15) * 4;
        __syncthreads();
        { const int sc = (tid & 15) * 8;
#pragma unroll
            for (int i = 0; i < 4; ++i) { const int row = (tid >> 4) + 32 * i;
                bf16x8 kv = {0, 0, 0, 0, 0, 0, 0, 0}, vv = {0, 0, 0, 0, 0, 0, 0, 0};
                if (row < NCMP) { const size_t ro = ((size_t)(b * NCMP + row) * 4 + g) * 128 + sc; kv = load8(kc + ro); vv = load8(vc + ro); }
                const int tile = row >> 6, r6 = row & 63;
                *(bf16x8*)(K_lds + tile * SHM_K + KSWZ(r6, sc * 2)) = kv;
                *(bf16x8*)(V_lds + tile * SHM_V + v_st(r6, sc)) = vv; } }
        __syncthreads();
        bf16x8 qr[8];
        { const att::bf16* qp = proj + (size_t)(b * T + tt0 * 32 + r32) * NP1 + O_Q + (g * 8 + wid) * 128 + hi * 8;
#pragma unroll
            for (int d0 = 0; d0 < 8; ++d0) qr[d0] = load8(qp + d0 * 16); }
        for (int ti = 0; ti < 4; ++ti) {
            const int t0 = (tt0 + ti) * 32, t = t0 + r32, hq = g * 8 + wid;
            f32x16 s[4];
            qkt<0, false>(s[0], s[1], K_lds, r32, hi, qr, true);
            qkt<1, false>(s[2], s[3], K_lds, r32, hi, qr, true);
            int nvalid = (t - 15) >> 4; nvalid = nvalid < 0 ? 0 : nvalid;
            const float NEG = -__builtin_inff(); float pmax = NEG;
#pragma unroll
            for (int q = 0; q < 4; ++q)
#pragma unroll
                for (int r = 0; r < 16; ++r) { const int c = (r & 3) + 8 * (r >> 2) + 4 * hi + 32 * q; if (c >= nvalid) s[q][r] = NEG; pmax = fmaxf(pmax, s[q][r]); }
            { auto rr = __builtin_amdgcn_permlane32_swap(__float_as_uint(pmax), __float_as_uint(pmax), false, false);
              pmax = fmaxf(__uint_as_float(rr[0]), __uint_as_float(rr[1])); }
            constexpr float C2 = 1.4426950408889634f * SCALE;
            const float mL = nvalid > 0 ? -pmax * C2 : 0.f;
            float ps = 0.f;
#pragma unroll
            for (int q = 0; q < 4; ++q)
#pragma unroll
                for (int r = 0; r < 16; ++r) { s[q][r] = __builtin_amdgcn_exp2f(fmaf(s[q][r], C2, mL)); ps += s[q][r]; }
            { auto rr = __builtin_amdgcn_permlane32_swap(__float_as_uint(ps), __float_as_uint(ps), false, false);
              ps = __uint_as_float(rr[0]) + __uint_as_float(rr[1]); }
            const float inv = nvalid > 0 ? 1.0f / ps : 0.f;
#pragma unroll
            for (int q = 0; q < 4; ++q)
#pragma unroll
                for (int r = 0; r < 16; ++r) s[q][r] *= inv;
            { float Gi[16], Lp[16];
#pragma unroll
                for (int i = 0; i < 16; ++i) { const int q = i >> 2, e = 4 * (i & 3);
                    Gi[i] = (s[q][e] + s[q][e + 1]) + (s[q][e + 2] + s[q][e + 3]); Lp[i] = __shfl_xor(s[q][e + 3], 32); }
                float* iw = impw + (wid * 32 + r32) * 33;
#pragma unroll
                for (int i = 0; i < 16; ++i) { const float prev = hi ? Lp[i] : (i > 0 ? Lp[i > 0 ? i - 1 : 0] : 0.f); iw[2 * i + hi] = Gi[i] + prev; } }
            bf16x8 pa0, pa1, pa2, pa3, pb0, pb1, pb2, pb3;
            PK4(s[0], 0, pa0); PK4(s[0], 8, pa1); PK4(s[1], 0, pa2); PK4(s[1], 8, pa3);
            PK4(s[2], 0, pb0); PK4(s[2], 8, pb1); PK4(s[3], 0, pb2); PK4(s[3], 8, pb3);
            f32x16 o[4] = {};
            pv_tile<0, false>(o, vb0, pa0, pa1, pa2, pa3, true);
            pv_tile<1, false>(o, vb0, pb0, pb1, pb2, pb3, true);
            { const int tn = (ti < 3 ? t0 + 32 : t0) + r32; const att::bf16* qp = proj + (size_t)(b * T + tn) * NP1 + O_Q + hq * 128 + hi * 8;
#pragma unroll
                for (int d0 = 0; d0 < 8; ++d0) qr[d0] = load8(qp + d0 * 16); }
            att::bf16* Ow = ocmp + (size_t)(b * T + t0) * D + hq * 128;
            { const unsigned short* Wp = owin + (size_t)(b * T + t0) * D + hq * 128; const float* Gp = gates + (size_t)(b * T + t0) * 96 + hq * 3;
#pragma unroll
                for (int q = 0; q < 4; ++q) { const unsigned rb = (unsigned)(8 * q + 4 * hi);
                    float gc[4], gw[4], wv[4][4];
#pragma unroll
                    for (int e = 0; e < 4; ++e) { gc[e] = Gp[(rb + e) * 96]; gw[e] = Gp[(rb + e) * 96 + 2];
#pragma unroll
                        for (int d0 = 0; d0 < 4; ++d0) wv[d0][e] = __uint_as_float((unsigned)Wp[(rb + e) * D + d0 * 32 + r32] << 16); }
#pragma unroll
                    for (int e = 0; e < 4; ++e)
#pragma unroll
                        for (int d0 = 0; d0 < 4; ++d0) { const float v = o[d0][4 * q + e] * gc[e] + wv[d0][e] * gw[e], vn = __shfl_xor(v, 1);
                            if ((r32 & 1) == 0) *(unsigned*)(Ow + (rb + e) * D + d0 * 32 + r32) = cvtpk(v, vn); }
                    asm volatile("" ::: "memory"); } }
            __syncthreads();
#pragma unroll
            for (int k = 0; k < 2; ++k) { const int idx = tid + 512 * k, tok = idx >> 5, j = idx & 31; float a = 0.f;
#pragma unroll
                for (int w = 0; w < 8; ++w) a += impw[(w * 32 + tok) * 33 + j];
                imps[tok * 33 + j] = a; }
            __syncthreads();
#pragma unroll
            for (int k = 0; k < 2; ++k) { const int idx = tid + 512 * k, tok = idx >> 5, j = idx & 31, tq = t0 + tok, blk = tq >> 6;
                bool sel;
                if (blk <= 15) sel = j <= blk;
                else { const bool forced = (j == 0) || (j == blk) || (j == blk - 1), cand = (j >= 1) && (j <= blk - 2);
                    const float v = imps[tok * 33 + j]; int rank = 0;
                    for (int jj = 1; jj <= blk - 2; ++jj) { const float x = imps[tok * 33 + jj]; rank += (x > v || (x == v && jj < j)) ? 1 : 0; }
                    sel = forced || (cand && rank < 13); }
                const unsigned long long bal = __ballot(sel); const unsigned m32 = (lane < 32) ? (unsigned)bal : (unsigned)(bal >> 32);
                if (j == 0) selm[(size_t)bg * T + tq] = m32; }
        }
    }
}

struct MkFox { const bf16* proj; bf16* mix; const float* cum; const float* nmax;
    __device__ __forceinline__ att::BlockRef<att::bf16> operator()(int bh, int qb) const { const int b = bh >> 4, h = bh & 15; att::BlockRef<att::bf16> r;
        r.Q = (const att::bf16*)(proj + (size_t)(b * T + qb * 256) * NP0 + E_FQ + h * 128); r.K = (const att::bf16*)(proj + (size_t)(b * T) * NP0 + E_FK + h * 128);
        r.V = (const att::bf16*)(proj + (size_t)(b * T) * NP0 + E_FV + h * 128); r.O = (att::bf16*)(mix + (size_t)(b * T + qb * 256) * D + h * 128);
        r.X = cum + (size_t)bh * T; r.Y = nullptr; r.Z = nullptr; r.P0 = qb * 256;
        { const int lane = threadIdx.x & 63; float km2 = 0.f;
#pragma unroll
            for (int j = 0; j < 8; ++j) { const float v = nmax[512 + bh * 8 + j]; km2 = (j <= qb && v > km2) ? v : km2; }
            const float bound = 2.0f * 0.08838834764831845f * sqrtf(nmax[bh * 8 + qb]) * sqrtf(km2) * 1.001f;
            const float c0 = cum[(size_t)bh * T + qb * 256], cj = cum[(size_t)bh * T + 64 * (lane & 31) + 63];
            const unsigned skip = (unsigned)__ballot(c0 - cj + bound < -110.0f);
            r.J0 = __builtin_ctz(~skip | 0x80000000u); }
        return r; } };
struct MkDiff { const bf16* proj; att::bf16* O1; att::bf16* O2;
    __device__ __forceinline__ att::BlockRef<att::bf16> operator()(int bh, int qb) const { const int b = bh >> 5, rem = bh & 31, h = rem >> 2, c = (rem >> 1) & 1, e = rem & 1; att::BlockRef<att::bf16> r;
        r.Q = (const att::bf16*)(proj + (size_t)(b * T + qb * 256) * NP0 + E_DQ + h * 256 + c * 128); r.K = (const att::bf16*)(proj + (size_t)(b * T) * NP0 + E_DK + h * 256 + c * 128);
        r.V = (const att::bf16*)(proj + (size_t)(b * T) * NP0 + E_DV + h * 256 + e * 128); r.O = (c ? O2 : O1) + (size_t)(b * T + qb * 256) * 2048 + h * 256 + e * 128;
        r.X = nullptr; r.Y = nullptr; r.Z = nullptr; r.P0 = qb * 256; r.J0 = 0; return r; } };
struct MkNsa { const bf16* qrot; const bf16* proj; att::bf16* O; const unsigned* selm; int kcol, vcol; const bf16* addend; const float* gates;
    __device__ __forceinline__ att::BlockRef<att::bf16> operator()(int bh, int qb) const { const int b = bh >> 5, h = bh & 31, g = h >> 3; att::BlockRef<att::bf16> r;
        r.Q = (const att::bf16*)(qrot + (size_t)(b * T + qb * 256) * D + h * 128); r.K = (const att::bf16*)(proj + (size_t)(b * T) * NP1 + kcol + g * 128);
        r.V = (const att::bf16*)(proj + (size_t)(b * T) * NP1 + vcol + g * 128); r.O = O + (size_t)(b * T + qb * 256) * D + h * 128;
        r.X = selm + (size_t)(b * 4 + g) * T; r.Y = addend + (size_t)(b * T + qb * 256) * D + h * 128; r.Z = gates + (size_t)(b * T + qb * 256) * 96 + h * 3 + 1; r.P0 = qb * 256; r.J0 = 0; return r; } };

constexpr int NPH = 28;
static_assert(sizeof(Args) == 31 * 8 + 8, "Args has no padding");

__global__ void __launch_bounds__(NWAVES * 64, 2) hybrid_fwd(Args args) {
    extern __shared__ __attribute__((aligned(16))) unsigned char lds[];
    LAS unsigned char* ldsl = (LAS unsigned char*)lds;
    Ctx C0; Ctx& C = C0;
    C.tid = threadIdx.x; C.lane = C.tid & 63; C.wave = __builtin_amdgcn_readfirstlane(C.tid >> 6); C.G = gridDim.x; C.bid = blockIdx.x;
    C.gw = C.bid * NWAVES + C.wave; C.NGW = C.G * NWAVES; C.ws = args.ws; C.out = args.out;
    for (int u = C.tid; u < (LDS_BYTES - RING_BYTES) / 4; u += NWAVES * 64) ((LAS unsigned*)(ldsl + RING_BYTES))[u] = 0u;
    __syncthreads();
    XcdBarrier bar = xcd_barrier_post((unsigned*)(C.ws + WS_CTL) + CW_BAR, (volatile LAS unsigned*)(ldsl + MISC_OFF) + 8);
    const int lo = args.ph_lo, hi = args.ph_hi;
#ifdef ONLY_PH
#define IN(k) ((k) == ONLY_PH && lo <= (k) && (k) < hi)
#else
#define IN(k) (lo <= (k) && (k) < hi)
#endif
#define SEAM(k) do { if (IN(k) && IN((k) + 1)) xcd_barrier(bar); } while (0)
    unsigned char* ws = C.ws;
    bf16* XN = (bf16*)(ws + WS_XN); bf16* MIX = (bf16*)(ws + WS_MIX); bf16* PROJ = (bf16*)(ws + WS_PROJ); bf16* HID = (bf16*)(ws + WS_SCR);
    bf16* H = (bf16*)(ws + WS_H); float* PART = (float*)(ws + WS_PART); LAS float* RS = (LAS float*)(ldsl + RS_OFF);

#define PREP_RS() int pm0 = -1; { pg8::Unit u0; if (S.next(0, u0)) { pm0 = u0.pm; prep_rstd(PART, pm0, RS, C.tid); } } \
        const pg8::RowScale RSC{(const PG8_LAS float*)RS, pm0, PART, 1.0f / D, RMS_EPS}
#define XCD_DEAL(c_, G_) (((G_) % 8 == 0) ? ((c_) % 8) * ((G_) / 8) + (c_) / 8 : (c_))
#define GEMM_GU(f, ap) do { pg8::Gemm g{(ap), (const bf16*)(ws + WS_WGU + (size_t)(f) * SZ_WGU), M, 2 * FF, D, D, 0, 0}; pg8::StaticOrder S; S.init(M, 2 * FF, C.G, C.bid); PREP_RS(); \
        pg8::EpiSwiGLU E{HID, M, RSC}; pg8::gemm_phase<pg8::EpiSwiGLU, pg8::StaticOrder, true, true>(ldsl, g, S, E); } while (0)
#define GEMM_DOWN(f, basep) do { pg8::Gemm g{HID, (const bf16*)(ws + WS_WD + (size_t)(f) * SZ_WD), M, D, FF, FF, 1, 1}; pg8::StaticOrder S; S.init(M, D, C.G, C.bid); \
        pg8::EpiResid<false> E{(basep), H, D, 0.5f, PART}; pg8::gemm_phase<pg8::EpiResid<false>, pg8::StaticOrder, true, true>(ldsl, g, S, E); } while (0)
#define GEMM_DOWN_X(f, xp) do { pg8::Gemm g{HID, (const bf16*)(ws + WS_WD + (size_t)(f) * SZ_WD), M, D, FF, FF, 1, 1}; pg8::StaticOrder S; S.init(M, D, C.G, C.bid); \
        pg8::EpiResid<true> E{(xp), H, D, 0.5f, PART}; pg8::gemm_phase<pg8::EpiResid<true>, pg8::StaticOrder, true, true>(ldsl, g, S, E); } while (0)
#define GEMM_OUT(wsoff) do { pg8::Gemm g{MIX, (const bf16*)(ws + (wsoff)), M, D, D, D, 0, 0}; pg8::StaticOrder S; S.init(M, D, C.G, C.bid); \
        pg8::EpiResid<false> E{H, H, D, 1.0f, PART}; pg8::gemm_phase<pg8::EpiResid<false>, pg8::StaticOrder, true, true>(ldsl, g, S, E); } while (0)

#ifndef DUP_PH
#define DUP_PH (-1)
#endif
#define PHASE_CTX Ctx C = C0; { int t_ = threadIdx.x; asm volatile("" : "+v"(t_)); C.tid = t_; C.lane = t_ & 63; }
#define PHASE(k, ...) do { if (IN(k)) { PHASE_CTX __VA_ARGS__ } SEAM(k); if (DUP_PH == (k) && IN(k)) { PHASE_CTX __VA_ARGS__ xcd_barrier(bar); } } while (0)
#define PHASE_LAST(k, ...) do { if (IN(k)) { PHASE_CTX __VA_ARGS__ } } while (0)
    PHASE(0, prologue_phase(args, C, ldsl););
#define TAIL(first, lo_, hi_) do { const int f_ = (C.G == 256) ? (first) : 0;     \
        if (C.bid >= f_) convert_range(args, ws, (lo_), (hi_), (C.bid - f_) * NWAVES + C.wave, (C.G - f_) * NWAVES, C.lane); } while (0)
    PHASE(1, GEMM_GU(0, XN); TAIL(192, T1_LO, T1_HI););
    PHASE(2, GEMM_DOWN_X(0, args.in[0]););
    PHASE(4, pg8::Gemm g{H, (const bf16*)(ws + WS_WIN0), M, NP0, D, D, 0, 0}; pg8::StaticOrder S; S.init(M, NP0, C.G, C.bid); PREP_RS();
        pg8::EpiProj E{PROJ, NP0, E_FG / 256, (float*)(ws + WS_FG), 16, 16, 0, RSC}; pg8::gemm_phase<pg8::EpiProj, pg8::StaticOrder, true, true>(ldsl, g, S, E); TAIL(32, T4_LO, T4_HI););
    PHASE(5, even_post_phase(args, C););
#define CONV_ALL(lo_, hi_) do { int l_ = threadIdx.x & 63; asm volatile("" : "+v"(l_)); convert_range(args, ws, (lo_), (hi_), C.gw, C.NGW, l_); } while (0)
#define ATT_CONV6() do { CONV_ALL(CB_WO0, T4_LO); CONV_ALL(T4_HI, T10_LO); CONV_ALL(T10_HI, T13_LO); CONV_ALL(T13_HI, T16_LO); } while (0)
    PHASE(6, if (!(C.bid & 1)) ATT_CONV6();
        MkFox mf{PROJ, MIX, (const float*)(ws + WS_CUM), (const float*)(ws + WS_NMAX)};
        att::attn_stream<1, false, att::bf16, NP0, NP0, NP0, D>((char*)lds, T, CAUSAL_W, BATCH * 16, C.G, XCD_DEAL(C.bid, C.G), mf);
        MkDiff md{PROJ, (att::bf16*)(ws + WS_SCR), (att::bf16*)(ws + WS_SCR) + (size_t)M * 2048};
        att::attn_stream<0, false, att::bf16, NP0, NP0, NP0, 2048>((char*)lds, T, CAUSAL_W, BATCH * 32, C.G, XCD_DEAL(C.bid, C.G), md);
        if (C.bid & 1) ATT_CONV6(););
    PHASE(7, even_combine_phase(args, C););
    PHASE(8, GEMM_OUT(WS_WOUT0););
    PHASE(10, GEMM_GU(1, H); TAIL(192, T10_LO, T10_HI););
    PHASE(11, GEMM_DOWN(1, H););
    PHASE(13, GEMM_GU(2, H); TAIL(192, T13_LO, T13_HI););
    PHASE(14, GEMM_DOWN(2, H););
    PHASE(16, pg8::Gemm g{H, (const bf16*)(ws + WS_WIN1), M, NP1, D, D, 0, 0}; pg8::StaticOrder S; S.init(M, NP1, C.G, C.bid); PREP_RS();
        pg8::EpiProj E{PROJ, NP1, O_GT / 256, (float*)(ws + WS_GATES), 96, 96, 1, RSC}; pg8::gemm_phase<pg8::EpiProj, pg8::StaticOrder, true, true>(ldsl, g, S, E); TAIL(160, T16_LO, T16_HI););
    PHASE(17, odd_post_phase(args, C););
    PHASE(18, pg8::Gemm g{(const bf16*)(ws + WS_ACMP), (const bf16*)(ws + WS_W1C), 4096, 512, 4096, 4096, 0, 0}; pg8::CmpOrder S{C.bid};
        pg8::EpiCmp E{(bf16*)(ws + WS_HIDC), (const float*)(ws + WS_CB)}; pg8::gemm_phase<pg8::EpiCmp, pg8::CmpOrder, true, true>(ldsl, g, S, E);
        { att::bf16* owin = (att::bf16*)(ws + WS_SCR) + (size_t)2 * M * D;
            MkNsa mw{(const bf16*)(ws + WS_QROT), PROJ, owin, (const unsigned*)(ws + WS_SELM), O_KW, O_VW, (const bf16*)(ws + WS_SCR), (const float*)(ws + WS_GATES)};
            const int skipw = C.G > 32 ? 16 : 0;
            if (C.bid >= skipw) att::attn_stream<0, true, att::bf16, D, NP1, NP1, D>((char*)lds, T, WINDOW, BATCH * 32, C.G - skipw, XCD_DEAL(C.bid - skipw, C.G - skipw), mw); });
    PHASE(19, cmp2_phase(args, C););
    PHASE(20, cmp_attn_phase(C, (char*)lds););
    PHASE(21, if (!(C.bid & 1)) CONV_ALL(T16_HI, T25_LO);
        MkNsa ms{(const bf16*)(ws + WS_QROT), PROJ, (att::bf16*)MIX, (const unsigned*)(ws + WS_SELM), O_KS, O_VS, (const bf16*)(ws + WS_SCR), (const float*)(ws + WS_GATES)};
        att::attn_stream<2, false, att::bf16, D, NP1, NP1, D>((char*)lds, T, CAUSAL_W, BATCH * 32, C.G, XCD_DEAL(C.bid, C.G), ms);
        if (C.bid & 1) CONV_ALL(T16_HI, T25_LO););
    PHASE(23, GEMM_OUT(WS_WOUT1););
    PHASE(25, GEMM_GU(3, H); TAIL(192, T25_LO, T25_HI););
    PHASE(26, GEMM_DOWN(3, H););
    PHASE_LAST(27, final_norm_phase(C, H, args.in[28], C.out););
#undef IN
#undef SEAM
}

#ifndef MK_SPLIT
#define MK_SPLIT 0
#endif
extern "C" void kernel_launch(void* const* d_in, const int* in_sizes, int n_in, void* d_out, int out_size, void* d_ws, size_t ws_size, hipStream_t stream) {
    static int grid = 0;
    if (grid == 0) {
        if (n_in != 29 || out_size != M * D || ws_size < WS_END) { fprintf(stderr, "kernel_launch: unexpected shapes (n_in %d out %d ws %zu need %zu)\n", n_in, out_size, ws_size, (size_t)WS_END); grid = -1; return; }
        int dev = 0, cus = 0, per_cu = 0;
        if (hipGetDevice(&dev) != hipSuccess || hipDeviceGetAttribute(&cus, hipDeviceAttributeMultiprocessorCount, dev) != hipSuccess) { grid = -1; return; }
        if (hipFuncSetAttribute((const void*)hybrid_fwd, hipFuncAttributeMaxDynamicSharedMemorySize, LDS_BYTES) != hipSuccess) { fprintf(stderr, "kernel_launch: hipFuncSetAttribute failed\n"); grid = -1; return; }
        if (hipOccupancyMaxActiveBlocksPerMultiprocessor(&per_cu, (const void*)hybrid_fwd, NWAVES * 64, LDS_BYTES) != hipSuccess || per_cu < 1)
            fprintf(stderr, "kernel_launch: occupancy query reports %d workgroups per CU\n", per_cu);
        (void)hipGetLastError();
        grid = cus;
    }
    if (grid < 0) return;
    (void)hipMemsetAsync((char*)d_ws + WS_CTL, 0, CTL_ZERO_BYTES, stream);
    Args a{};
    for (int i = 0; i < 29; ++i) a.in[i] = (const float*)d_in[i];
    a.out = (float*)d_out; a.ws = (unsigned char*)d_ws;
#if MK_SPLIT
    for (int p = 0; p < NPH; ++p) { a.ph_lo = p; a.ph_hi = p + 1; hipLaunchKernelGGL(hybrid_fwd, dim3(grid), dim3(NWAVES * 64), LDS_BYTES, stream, a); }
#else
    a.ph_lo = 0; a.ph_hi = NPH; hipLaunchKernelGGL(hybrid_fwd, dim3(grid), dim3(NWAVES * 64), LDS_BYTES, stream, a);
#endif
}
```
